# Optimizing an MI355X kernel written in HIP

```python
import jax, jax.numpy as jnp
from jax import lax
import numpy as np

D_MODEL = 1024
BATCH = 8
SEQ = 2048
DEPTH = 2

N_A = DEPTH // 2
N_B = DEPTH - N_A
N_DENSE = (DEPTH + 1) // 2
N_MOE = DEPTH // 2

N_MEM = 256
M_HEADS = 4
M_HEAD_DIM = 64
M_W = M_HEADS * M_HEAD_DIM

A_HEADS = 4
A_QK_DIM = 96
A_V_DIM = 192
A_CHUNK = 64
A_QK_W = A_HEADS * A_QK_DIM
A_V_W = A_HEADS * A_V_DIM
A_IN = 2 * A_QK_W + 2 * A_V_W + 2 * A_HEADS + M_W
MIX_A = A_V_W + M_W

B_HEADS = 6
Q_LORA = 384
KV_LORA = 256
QK_NOPE = 128
QK_ROPE = 64
V_HEAD = 128
B_QK_HEAD = QK_NOPE + QK_ROPE
B_IN = Q_LORA + M_W
MIX_B = B_HEADS * V_HEAD + M_W
ROPE_THETA = 10000.0
Q_BLOCK = 128

D_FF = 3584
N_EXPERTS = 8
TOP_K = 2

EPS = 1e-6

kernel_name = "yoco_mlstm_mla_memory_moe_block"


def rms_norm(x, g):
    xf = x.astype(jnp.float32)
    y = xf * lax.rsqrt(jnp.mean(xf * xf, axis=-1, keepdims=True) + EPS)
    return (y * g.astype(jnp.float32)).astype(x.dtype)


def rope_angles(positions):
    inv = 1.0 / (ROPE_THETA ** (jnp.arange(0, QK_ROPE, 2, dtype=jnp.float32) / QK_ROPE))
    ang = positions.astype(jnp.float32)[..., None] * inv
    return jnp.cos(ang), jnp.sin(ang)


def apply_rope(x, cos, sin):
    x1, x2 = jnp.split(x.astype(jnp.float32), 2, axis=-1)
    return jnp.concatenate([x1 * cos - x2 * sin, x2 * cos + x1 * sin], axis=-1).astype(x.dtype)


def memory_kv(mem, norm_g, w_kv):
    B, M, _ = mem.shape
    kv = rms_norm(mem, norm_g) @ w_kv
    k, v = jnp.split(kv, 2, axis=-1)
    return k.reshape(B, M, M_HEADS, M_HEAD_DIM), v.reshape(B, M, M_HEADS, M_HEAD_DIM)


def memory_attention(q, mem_k, mem_v, q_g, k_g):
    B, S = q.shape[:2]
    q = rms_norm(q, q_g)
    k = rms_norm(mem_k, k_g)
    s = jnp.einsum('bshd,bmhd->bhsm', q, k).astype(jnp.float32) * (M_HEAD_DIM ** -0.5)
    p = jax.nn.softmax(s, axis=-1).astype(mem_v.dtype)
    return jnp.einsum('bhsm,bmhd->bshd', p, mem_v).reshape(B, S, M_W)


def mlstm_chunkwise(q, k, v, i_pre, f_pre):
    B, S, H, dk = q.shape
    dv = v.shape[-1]
    L = A_CHUNK
    NC = S // L
    f32 = jnp.float32

    def chunk(t):
        return t.astype(f32).reshape(B, NC, L, H, -1).transpose(0, 3, 1, 2, 4)

    def chunk_gate(t):
        return t.astype(f32).reshape(B, NC, L, H).transpose(0, 3, 1, 2)

    qc = chunk(q)
    kc = chunk(k) * (dk ** -0.5)
    vc = chunk(v)
    ig = chunk_gate(i_pre)
    lf = jax.nn.log_sigmoid(chunk_gate(f_pre))
    g = jnp.cumsum(lf, axis=-1)
    g_last = g[..., -1]

    w_loc = g_last[..., None] - g + ig
    m_loc = jnp.max(w_loc, axis=-1)
    e_loc = jnp.exp(w_loc - m_loc[..., None])
    C_loc = jnp.einsum('bhcld,bhcle->bhcde', vc * e_loc[..., None], kc)
    n_loc = jnp.einsum('bhcl,bhcle->bhce', e_loc, kc)

    def step(carry, xs):
        C, n, m = carry
        Cl, nl, ml, gl = xs
        m_new = jnp.maximum(gl + m, ml)
        a = jnp.exp(gl + m - m_new)
        b = jnp.exp(ml - m_new)
        C_new = a[..., None, None] * C + b[..., None, None] * Cl
        n_new = a[..., None] * n + b[..., None] * nl
        return (C_new, n_new, m_new), (C, n, m)

    init = (jnp.zeros((B, H, dv, dk), f32), jnp.zeros((B, H, dk), f32), jnp.zeros((B, H), f32))
    xs = (jnp.moveaxis(C_loc, 2, 0), jnp.moveaxis(n_loc, 2, 0),
          jnp.moveaxis(m_loc, 2, 0), jnp.moveaxis(g_last, 2, 0))
    _, (C_prev, n_prev, m_prev) = lax.scan(step, init, xs)
    C_prev = jnp.moveaxis(C_prev, 0, 2)
    n_prev = jnp.moveaxis(n_prev, 0, 2)
    m_prev = jnp.moveaxis(m_prev, 0, 2)

    a_log = g + m_prev[..., None]
    causal = jnp.tril(jnp.ones((L, L), dtype=bool))
    d_log = jnp.where(causal, g[..., :, None] - g[..., None, :] + ig[..., None, :], -jnp.inf)
    m_t = jnp.maximum(a_log, jnp.max(d_log, axis=-1))
    inter = jnp.exp(a_log - m_t)
    P = jnp.exp(d_log - m_t[..., None]) * jnp.einsum('bhctd,bhcsd->bhcts', qc, kc)
    num = inter[..., None] * jnp.einsum('bhcde,bhcte->bhctd', C_prev, qc) \
        + jnp.einsum('bhcts,bhcsd->bhctd', P, vc)
    den = inter * jnp.einsum('bhce,bhcte->bhct', n_prev, qc) + jnp.sum(P, axis=-1)
    h = num / jnp.maximum(jnp.abs(den), jnp.exp(-m_t))[..., None]
    return h.transpose(0, 2, 3, 1, 4).reshape(B, S, H, dv)


def mlstm_layer(x, norm_g, w_in, gate_bias, head_g, w_out, mem_k, mem_v, mq_g, mk_g):
    B, S, _ = x.shape
    proj = rms_norm(x, norm_g) @ w_in
    offs = [A_QK_W, 2 * A_QK_W, 2 * A_QK_W + A_V_W, 2 * A_QK_W + 2 * A_V_W,
            2 * A_QK_W + 2 * A_V_W + 2 * A_HEADS]
    q, k, v, o, ifg, mq = jnp.split(proj, offs, axis=-1)
    ifg = ifg + gate_bias
    i_pre, f_pre = ifg[..., :A_HEADS], ifg[..., A_HEADS:]
    hm = mlstm_chunkwise(q.reshape(B, S, A_HEADS, A_QK_DIM), k.reshape(B, S, A_HEADS, A_QK_DIM),
                         v.reshape(B, S, A_HEADS, A_V_DIM), i_pre, f_pre).astype(x.dtype)
    hm = rms_norm(hm, head_g.reshape(A_HEADS, A_V_DIM)).reshape(B, S, A_V_W)
    hm = hm * jax.nn.sigmoid(o)
    mo = memory_attention(mq.reshape(B, S, M_HEADS, M_HEAD_DIM), mem_k, mem_v, mq_g, mk_g)
    return x + jnp.concatenate([hm, mo], axis=-1) @ w_out


def shared_latent_kv(h, kv_norm, w_dkv, kv_a_norm, w_ukv, k_head_g, cos, sin):
    B, S, _ = h.shape
    z = rms_norm(h, kv_norm) @ w_dkv
    c_kv, k_rope = z[..., :KV_LORA], z[..., KV_LORA:]
    kv = (rms_norm(c_kv, kv_a_norm) @ w_ukv).reshape(B, S, B_HEADS, QK_NOPE + V_HEAD)
    k_nope, v = kv[..., :QK_NOPE], kv[..., QK_NOPE:]
    k = jnp.concatenate([k_nope, jnp.broadcast_to(k_rope[:, :, None, :], (B, S, B_HEADS, QK_ROPE))], axis=-1)
    k = rms_norm(k, k_head_g)
    k = jnp.concatenate([k[..., :QK_NOPE],
                         apply_rope(k[..., QK_NOPE:], cos[:, :, None], sin[:, :, None])], axis=-1)
    return k, v


def causal_block_attention(q, k, v):
    B, S, H, dq = q.shape
    scale = dq ** -0.5
    qt = q.transpose(0, 2, 1, 3)
    kt = k.transpose(0, 2, 1, 3)
    vt = v.transpose(0, 2, 1, 3)
    local_mask = jnp.tril(jnp.ones((Q_BLOCK, Q_BLOCK), dtype=bool))
    outs = []
    for blk in range(S // Q_BLOCK):
        start = blk * Q_BLOCK
        end = start + Q_BLOCK
        s = jnp.einsum('bhqd,bhkd->bhqk', qt[:, :, start:end], kt[:, :, :end]).astype(jnp.float32) * scale
        mask = jnp.concatenate([jnp.ones((Q_BLOCK, start), dtype=bool), local_mask], axis=1)
        p = jax.nn.softmax(jnp.where(mask, s, -jnp.inf), axis=-1).astype(v.dtype)
        outs.append(jnp.einsum('bhqk,bhkd->bqhd', p, vt[:, :, :end]))
    return jnp.concatenate(outs, axis=1)


def mla_layer(x, norm_g, w_in, q_a_g, w_uq, q_head_g, w_out, k_sh, v_sh, cos, sin,
              mem_k, mem_v, mq_g, mk_g):
    B, S, _ = x.shape
    proj = rms_norm(x, norm_g) @ w_in
    cq, mq = proj[..., :Q_LORA], proj[..., Q_LORA:]
    q = (rms_norm(cq, q_a_g) @ w_uq).reshape(B, S, B_HEADS, B_QK_HEAD)
    q = rms_norm(q, q_head_g)
    q = jnp.concatenate([q[..., :QK_NOPE],
                         apply_rope(q[..., QK_NOPE:], cos[:, :, None], sin[:, :, None])], axis=-1)
    att = causal_block_attention(q, k_sh, v_sh).reshape(B, S, B_HEADS * V_HEAD)
    mo = memory_attention(mq.reshape(B, S, M_HEADS, M_HEAD_DIM), mem_k, mem_v, mq_g, mk_g)
    return x + jnp.concatenate([att, mo], axis=-1) @ w_out


def swiglu(h, w_gate_up, w_down):
    g, u = jnp.split(h @ w_gate_up, 2, axis=-1)
    return (jax.nn.silu(g) * u) @ w_down


def moe_ffn(h, router, w_gate_up, w_down):
    B, S, D = h.shape
    t = h.reshape(B * S, D)
    logits = (t @ router).astype(jnp.float32)
    top_v, top_i = lax.top_k(logits, TOP_K)
    gates = jax.nn.softmax(top_v, axis=-1)
    combine = jnp.sum(jax.nn.one_hot(top_i, N_EXPERTS, dtype=jnp.float32) * gates[..., None], axis=1)
    out = jnp.zeros_like(t)
    for e in range(N_EXPERTS):
        out = out + combine[:, e:e + 1].astype(t.dtype) * swiglu(t, w_gate_up[e], w_down[e])
    return out.reshape(B, S, D)


def setup_inputs(seed: int = 0) -> dict:
    key = jax.random.key(seed)
    ks = iter(jax.random.split(key, 40))
    f32 = jnp.float32

    def w(shape, fan_in):
        return jax.random.normal(next(ks), shape, f32) * (fan_in ** -0.5)

    def gain(shape):
        return 1.0 + 0.02 * jax.random.normal(next(ks), shape, f32)

    x = jax.random.normal(next(ks), (BATCH, SEQ, D_MODEL), f32)
    mem = jax.random.normal(next(ks), (BATCH, N_MEM, D_MODEL), f32)
    offset = jax.random.randint(next(ks), (BATCH, 1), 0, 4096, dtype=jnp.int32)
    positions = jnp.arange(SEQ, dtype=jnp.int32)[None, :] + offset

    i_bias = 0.1 * jax.random.normal(next(ks), (N_A, A_HEADS), f32)
    f_bias = 3.0 + 0.1 * jax.random.normal(next(ks), (N_A, A_HEADS), f32)

    return {
        "x": x, "mem": mem, "positions": positions,
        "a_norm": gain((N_A, D_MODEL)),
        "a_w_in": w((N_A, D_MODEL, A_IN), D_MODEL),
        "a_gate_bias": jnp.concatenate([i_bias, f_bias], axis=-1),
        "a_head_norm": gain((N_A, A_V_W)),
        "a_w_out": w((N_A, MIX_A, D_MODEL), MIX_A),
        "b_norm": gain((N_B, D_MODEL)),
        "b_w_in": w((N_B, D_MODEL, B_IN), D_MODEL),
        "b_q_a_norm": gain((N_B, Q_LORA)),
        "b_w_uq": w((N_B, Q_LORA, B_HEADS * B_QK_HEAD), Q_LORA),
        "b_q_head_norm": gain((N_B, B_QK_HEAD)),
        "b_w_out": w((N_B, MIX_B, D_MODEL), MIX_B),
        "kv_norm": gain((D_MODEL,)),
        "w_dkv": w((D_MODEL, KV_LORA + QK_ROPE), D_MODEL),
        "kv_a_norm": gain((KV_LORA,)),
        "w_ukv": w((KV_LORA, B_HEADS * (QK_NOPE + V_HEAD)), KV_LORA),
        "k_head_norm": gain((B_QK_HEAD,)),
        "mem_norm": gain((DEPTH, D_MODEL)),
        "mem_w_kv": w((DEPTH, D_MODEL, 2 * M_W), D_MODEL),
        "mem_q_norm": gain((DEPTH, M_HEAD_DIM)),
        "mem_k_norm": gain((DEPTH, M_HEAD_DIM)),
        "ffn_norm": gain((DEPTH, D_MODEL)),
        "dense_w_gate_up": w((N_DENSE, D_MODEL, 2 * D_FF), D_MODEL),
        "dense_w_down": w((N_DENSE, D_FF, D_MODEL), D_FF),
        "moe_router": w((N_MOE, D_MODEL, N_EXPERTS), D_MODEL),
        "moe_w_gate_up": w((N_MOE, N_EXPERTS, D_MODEL, 2 * D_FF), D_MODEL),
        "moe_w_down": w((N_MOE, N_EXPERTS, D_FF, D_MODEL), D_FF),
    }


def reference(x, mem, positions,
              a_norm, a_w_in, a_gate_bias, a_head_norm, a_w_out,
              b_norm, b_w_in, b_q_a_norm, b_w_uq, b_q_head_norm, b_w_out,
              kv_norm, w_dkv, kv_a_norm, w_ukv, k_head_norm,
              mem_norm, mem_w_kv, mem_q_norm, mem_k_norm,
              ffn_norm, dense_w_gate_up, dense_w_down,
              moe_router, moe_w_gate_up, moe_w_down):
    cos, sin = rope_angles(positions)
    k_sh = v_sh = None
    if N_A == 0:
        k_sh, v_sh = shared_latent_kv(x, kv_norm, w_dkv, kv_a_norm, w_ukv, k_head_norm, cos, sin)
    for l in range(DEPTH):
        mem_k, mem_v = memory_kv(mem, mem_norm[l], mem_w_kv[l])
        if l < N_A:
            x = mlstm_layer(x, a_norm[l], a_w_in[l], a_gate_bias[l], a_head_norm[l], a_w_out[l],
                            mem_k, mem_v, mem_q_norm[l], mem_k_norm[l])
        else:
            j = l - N_A
            x = mla_layer(x, b_norm[j], b_w_in[j], b_q_a_norm[j], b_w_uq[j], b_q_head_norm[j], b_w_out[j],
                          k_sh, v_sh, cos, sin, mem_k, mem_v, mem_q_norm[l], mem_k_norm[l])
        hf = rms_norm(x, ffn_norm[l])
        if l % 2 == 0:
            x = x + swiglu(hf, dense_w_gate_up[l // 2], dense_w_down[l // 2])
        else:
            x = x + moe_ffn(hf, moe_router[l // 2], moe_w_gate_up[l // 2], moe_w_down[l // 2])
        if l == N_A - 1:
            k_sh, v_sh = shared_latent_kv(x, kv_norm, w_dkv, kv_a_norm, w_ukv, k_head_norm, cos, sin)
    return x
```

```cpp
#define MK_ONE_LAUNCH 1
#define FFN2_FP8 1
#define L1_FP8 1
#define KFIN_FUSED 1
#define YP_FP8 1
#define ATT_WSKIP 0
#include <hip/hip_runtime.h>
#include <cstdio>
#include <cstdint>
#include <cmath>
namespace pg8 {
#define PG8_LAS __attribute__((address_space(3)))
typedef unsigned short bf16_t;
typedef short bf16x8 __attribute__((ext_vector_type(8)));
typedef float f32x4 __attribute__((ext_vector_type(4)));
typedef unsigned u32x4 __attribute__((ext_vector_type(4)));
typedef unsigned u32x2 __attribute__((ext_vector_type(2)));
constexpr int BM = 256, BK = 64, HALF = 128, HTB = HALF * BK * 2  , STAGE_BYTES = 8 * HTB, NXCD = 8, WGM = 8;

__host__ __device__ __forceinline__ int lds_byte(int r, int c) { const int st = (r >> 4) * 2 + (c >> 5), rr = r & 15, cc = c & 31, ob = rr * 64 + cc * 2; return st * 1024 + (ob ^ (((ob >> 9) & 1) << 5)); }
__host__ __device__ __forceinline__ void stage_rc(int b, int& R, int& C) { const int st = b / 1024, sb = b % 1024, swz = sb ^ (((sb >> 9) & 1) << 5); R = (st >> 1) * 16 + swz / 64; C = (st & 1) * 32 + (swz % 64) / 2; }
__host__ __device__ __forceinline__ int perm32(int rho) { const int n = rho >> 4, i = rho & 15; return 8 * (i >> 2) + 4 * n + (i & 3); }

struct Unit { int pm, pn; };
struct Gemm { const bf16_t* A; const bf16_t* Bt; int lda; int K; };

struct StaticOrder {
    int nM, nN, nwg, G, c;
    __host__ __device__ void init(int nM_, int nN_, int G_, int c_) { nM = nM_; nN = nN_; nwg = nM * nN; G = G_; c = c_; }
    __host__ __device__ bool next(int i, Unit& u) const {
        const long L = (long)i * G + c; if (L >= nwg) return false;
        int wgid = (int)L; { const int q = nwg / NXCD, r = nwg % NXCD, xcd = wgid % NXCD, off = wgid / NXCD; wgid = (xcd < r ? xcd * (q + 1) : r * (q + 1) + (xcd - r) * q) + off; }
        const int nig = WGM * nN, gid = wgid / nig, fm = gid * WGM, gsz = (nM - fm) < WGM ? (nM - fm) : WGM;
        u.pm = fm + ((wgid % nig) % gsz); u.pn = (wgid % nig) / gsz; return true;
    }
    __device__ __forceinline__ void a_ready(const Unit&) const {}
    __device__ __forceinline__ void done(const Unit&) const {}
};
struct MoeOrder {
    StaticOrder so; int tend[8];
    __device__ __forceinline__ bool next(int i, Unit& u) const {
        if (!so.next(i, u)) return false;
        int e = 0;
#pragma unroll
        for (int k = 0; k < 7; ++k) e += (u.pm >= tend[k]) ? 1 : 0;
        u.pn += e * so.nN; return true;
    }
    __device__ __forceinline__ void a_ready(const Unit&) const {}
    __device__ __forceinline__ void done(const Unit&) const {}
};

typedef __bf16 bf16v2 __attribute__((ext_vector_type(2)));
__device__ __forceinline__ unsigned cvt_pk_bf16(float lo, float hi) { bf16v2 v = {(__bf16)lo, (__bf16)hi}; return __builtin_bit_cast(unsigned, v); }

#ifndef MOE2_A_AUX
#define MOE2_A_AUX 0
#endif
#ifndef MOE2_B_AUX
#define MOE2_B_AUX 0
#endif
#ifndef MOE1_B_AUX
#define MOE1_B_AUX 0
#endif
#ifndef EPI_WT
#define EPI_WT 0
#endif
typedef int i32x4_ __attribute__((ext_vector_type(4))); typedef int i32x2_ __attribute__((ext_vector_type(2)));
template <class V> __device__ __forceinline__ void st_out(void* base, void* p, V v) {
    if constexpr (EPI_WT) { const __amdgpu_buffer_rsrc_t rs = __builtin_amdgcn_make_buffer_rsrc(base, 0, 0x7fffffff, 0x00020000); const int off = (int)((const char*)p - (const char*)base);
        if constexpr (sizeof(V) == 16) __builtin_amdgcn_raw_buffer_store_b128(__builtin_bit_cast(i32x4_, v), rs, off, 0, EPI_WT);
        else __builtin_amdgcn_raw_buffer_store_b64(__builtin_bit_cast(i32x2_, v), rs, off, 0, EPI_WT); }
    else *(V*)p = v;
}
typedef int i32x4 __attribute__((ext_vector_type(4)));
typedef int i32x8 __attribute__((ext_vector_type(8)));
__device__ __forceinline__ i32x8 cat8(bf16x8 a, bf16x8 b) { const i32x4 x = __builtin_bit_cast(i32x4, a), y = __builtin_bit_cast(i32x4, b); return __builtin_shufflevector(x, y, 0, 1, 2, 3, 4, 5, 6, 7); }
template <bool FP8> struct FragT { bf16x8 k[2]; };
template <> struct FragT<true> { i32x8 v; };
template <class Epi, class Sched, bool FP8 = false, bool ALIGN_EPI = true, bool SP2 = true, bool PEEL = !FP8>
__device__ __forceinline__ void gemm_phase(int tid, PG8_LAS unsigned char* lds, const Gemm g, const Sched& S, const Epi& E) {
    asm volatile("" : "+v"(tid));
    const int wid = __builtin_amdgcn_readfirstlane(tid >> 6), lane = tid & 63, wr = wid >> 2, wc = wid & 3, fr = lane & 15, fq = lane >> 4;
    const int K = g.K, nt = K / BK, lda = g.lda;
    unsigned voffA[2], voffB[2];
#pragma unroll
    for (int i = 0; i < 2; ++i) { int R, C; stage_rc(tid * 16 + i * 8192, R, C); const int Rb = Epi::PERM ? ((R & ~31) + perm32(R & 31)) : R;
        voffA[i] = (unsigned)(R * lda + C) * 2u; voffB[i] = (unsigned)(Rb * K + C) * 2u; }
    const unsigned kstep = (unsigned)(BK * 2);
    const unsigned hstepA = (unsigned)HALF * lda * 2u, hstepB = (unsigned)HALF * K * 2u;
    const unsigned tstepA = 2u * hstepA, tstepB = 2u * hstepB;
    const __amdgpu_buffer_rsrc_t rsA = __builtin_amdgcn_make_buffer_rsrc((void*)g.A, 0, 0x7fffffff, 0x00020000), rsB = __builtin_amdgcn_make_buffer_rsrc((void*)g.Bt, 0, 0x7fffffff, 0x00020000);
    const unsigned ldsw = (unsigned)wid * 1024u;
    const int aoff = lds_byte(wr * 64 + fr, fq * 8), boff = lds_byte(wc * 32 + fr, fq * 8);
#define PG8_SA(b, h) (((b) * 2 + (h)) * HTB)
#define PG8_SB(b, h) ((4 + (b) * 2 + (h)) * HTB)
#define PG8_STAGE_(rs, bufoff, soff, voff, aux) do { _Pragma("unroll") for (int _i = 0; _i < 2; ++_i) \
        __builtin_amdgcn_raw_ptr_buffer_load_lds(rs, (PG8_LAS void*)(lds + (bufoff) + ldsw + _i * 8192), 16, (voff)[_i], (soff), 0, aux); } while (0)
#define PG8_STAGEA(bufoff, soff) PG8_STAGE_(rsA, bufoff, soff, voffA, Epi::A_AUX)
#define PG8_STAGEB(bufoff, soff) PG8_STAGE_(rsB, bufoff, soff, voffB, Epi::B_AUX)
#define PG8_LDF(dst, base) do { if constexpr (FP8) { (dst).v.lo = *(const PG8_LAS i32x4*)(base); (dst).v.hi = *(const PG8_LAS i32x4*)((base) + 1024); } \
        else { (dst).k[0] = *(const PG8_LAS bf16x8*)(base); (dst).k[1] = *(const PG8_LAS bf16x8*)((base) + 1024); } } while (0)
#define PG8_LDA(dst, b, h) do { _Pragma("unroll") for (int m = 0; m < 4; ++m) PG8_LDF(dst[m], lds + PG8_SA(b, h) + aoff + m * 2048); } while (0)
#define PG8_LDB(dst, b, h) do { _Pragma("unroll") for (int n = 0; n < 2; ++n) PG8_LDF(dst[n], lds + PG8_SB(b, h) + boff + n * 2048); } while (0)
#define PG8_MMA_(ai, bj, At, Bt, CIN) do { __builtin_amdgcn_s_setprio(1); _Pragma("unroll") for (int m = 0; m < 4; ++m) _Pragma("unroll") for (int n = 0; n < 2; ++n) { \
        if constexpr (FP8) acc[ai][bj][m][n] = __builtin_amdgcn_mfma_scale_f32_16x16x128_f8f6f4(Bt[n].v, At[m].v, CIN, 0, 0, 0, (int)Epi::WSCALE, 0, 0x7F7F7F7F); \
        else { acc[ai][bj][m][n] = __builtin_amdgcn_mfma_f32_16x16x32_bf16(Bt[n].k[0], At[m].k[0], CIN, 0, 0, 0); acc[ai][bj][m][n] = __builtin_amdgcn_mfma_f32_16x16x32_bf16(Bt[n].k[1], At[m].k[1], acc[ai][bj][m][n], 0, 0, 0); } } \
        __builtin_amdgcn_s_setprio(0); } while (0)
#define PG8_MMA(ai, bj, At, Bt) PG8_MMA_(ai, bj, At, Bt, acc[ai][bj][m][n])
#define PG8_MMAZ(ai, bj, At, Bt) do { if constexpr (!PEEL) PG8_MMA_(ai, bj, At, Bt, acc[ai][bj][m][n]); else PG8_MMA_(ai, bj, At, Bt, zero4); } while (0)
#define PG8_WAIT_V(n) asm volatile("s_waitcnt vmcnt(" #n ")" ::: "memory")
#define PG8_WAIT_L(n) asm volatile("s_waitcnt lgkmcnt(" #n ")" ::: "memory")
#define PG8_BAR __builtin_amdgcn_s_barrier()
#define PG8_SCHED __builtin_amdgcn_sched_barrier(0)
    Unit cur, nxt; int ui = 0;
    if (!S.next(0, cur)) return;
    f32x4 acc[2][2][4][2];
    if constexpr (!PEEL) {
#pragma unroll
    for (int a = 0; a < 2; ++a)
#pragma unroll
            for (int b = 0; b < 2; ++b)
#pragma unroll
                for (int m = 0; m < 4; ++m)
#pragma unroll
                    for (int n = 0; n < 2; ++n) acc[a][b][m][n] = (f32x4){0.f, 0.f, 0.f, 0.f};
    }
    FragT<FP8> At[4], B0[2], B1[2]; const f32x4 zero4 = (f32x4){0.f, 0.f, 0.f, 0.f};
    unsigned cA = (unsigned)cur.pm * tstepA, cB = (unsigned)cur.pn * tstepB;
    S.a_ready(cur);
    if constexpr (SP2) {
        PG8_STAGEB(PG8_SB(0, 0), cB); PG8_STAGEB(PG8_SB(0, 1), cB + hstepB); PG8_STAGEA(PG8_SA(0, 0), cA); PG8_STAGEA(PG8_SA(0, 1), cA + hstepA);
        if (wr == 1) PG8_BAR;
        PG8_WAIT_V(2); PG8_BAR;
        PG8_STAGEB(PG8_SB(1, 0), cB + kstep); PG8_STAGEA(PG8_SA(1, 0), cA + kstep); PG8_STAGEB(PG8_SB(1, 1), cB + hstepB + kstep);
        PG8_WAIT_V(6); PG8_BAR;
    } else {
        PG8_STAGEB(PG8_SB(0, 0), cB); PG8_STAGEA(PG8_SA(0, 0), cA); PG8_STAGEB(PG8_SB(0, 1), cB + hstepB); PG8_STAGEA(PG8_SA(0, 1), cA + hstepA);
        if (wr == 1) PG8_BAR;
        PG8_WAIT_V(4); PG8_BAR;
        PG8_STAGEB(PG8_SB(1, 0), cB + kstep); PG8_STAGEA(PG8_SA(1, 0), cA + kstep); PG8_STAGEB(PG8_SB(1, 1), cB + hstepB + kstep);
        PG8_WAIT_V(6); PG8_BAR;
    }
    for (;;) {
        const bool has_next = S.next(ui + 1, nxt);
        const unsigned nA = has_next ? (unsigned)nxt.pm * tstepA : cA, nB = has_next ? (unsigned)nxt.pn * tstepB : cB;
        if constexpr (PEEL) { const int t = 0;
            const unsigned a1 = cA + (unsigned)(t + 1) * kstep;
            const unsigned a2 = cA + (unsigned)(t + 2) * kstep, b2 = cB + (unsigned)(t + 2) * kstep;
            const unsigned a3 = a2 + kstep, b3 = b2 + kstep;
            if constexpr (SP2) {
            PG8_LDB(B0, 0, 0); PG8_LDB(B1, 0, 1); PG8_SCHED; PG8_LDA(At, 0, 0); PG8_STAGEA(PG8_SA(1, 1), a1 + hstepA);
            PG8_WAIT_V(8); PG8_WAIT_L(0); PG8_BAR; PG8_SCHED; PG8_MMAZ(0, 0, At, B0); PG8_MMAZ(0, 1, At, B1); PG8_BAR; PG8_SCHED;
            PG8_LDA(At, 0, 1); PG8_STAGEB(PG8_SB(0, 0), b2); PG8_STAGEB(PG8_SB(0, 1), b2 + hstepB); PG8_STAGEA(PG8_SA(0, 0), a2);
            PG8_WAIT_V(8); PG8_WAIT_L(0); PG8_BAR; PG8_SCHED; PG8_MMAZ(1, 0, At, B0); PG8_MMAZ(1, 1, At, B1); PG8_BAR; PG8_SCHED;
            PG8_LDB(B0, 1, 0); PG8_LDB(B1, 1, 1); PG8_SCHED; PG8_LDA(At, 1, 0); PG8_STAGEA(PG8_SA(0, 1), a2 + hstepA);
            PG8_WAIT_V(8); PG8_WAIT_L(0); PG8_BAR; PG8_SCHED; PG8_MMA(0, 0, At, B0); PG8_MMA(0, 1, At, B1); PG8_BAR; PG8_SCHED;
            PG8_LDA(At, 1, 1); PG8_STAGEB(PG8_SB(1, 0), b3); PG8_STAGEB(PG8_SB(1, 1), b3 + hstepB); PG8_STAGEA(PG8_SA(1, 0), a3);
            PG8_WAIT_V(8); PG8_WAIT_L(0); PG8_BAR; PG8_SCHED; PG8_MMA(1, 0, At, B0); PG8_MMA(1, 1, At, B1); PG8_BAR; PG8_SCHED;
            } else {
            PG8_LDB(B0, 0, 0); PG8_SCHED; PG8_LDA(At, 0, 0); PG8_STAGEA(PG8_SA(1, 1), a1 + hstepA);
            PG8_WAIT_L(8); PG8_BAR; PG8_WAIT_L(0); PG8_MMAZ(0, 0, At, B0); PG8_BAR; PG8_SCHED;
            PG8_LDB(B1, 0, 1); PG8_STAGEB(PG8_SB(0, 0), b2);
            PG8_BAR; PG8_WAIT_L(0); PG8_MMAZ(0, 1, At, B1); PG8_BAR;
            PG8_LDA(At, 0, 1); PG8_STAGEA(PG8_SA(0, 0), a2);
            PG8_BAR; PG8_WAIT_L(0); PG8_MMAZ(1, 0, At, B0); PG8_BAR; PG8_SCHED;
            PG8_STAGEB(PG8_SB(0, 1), b2 + hstepB);
            PG8_WAIT_V(6); PG8_BAR; PG8_MMAZ(1, 1, At, B1); PG8_BAR;
            PG8_LDB(B0, 1, 0); PG8_SCHED; PG8_LDA(At, 1, 0); PG8_STAGEA(PG8_SA(0, 1), a2 + hstepA);
            PG8_WAIT_L(8); PG8_BAR; PG8_WAIT_L(0); PG8_MMA(0, 0, At, B0); PG8_BAR; PG8_SCHED;
            PG8_LDB(B1, 1, 1); PG8_STAGEB(PG8_SB(1, 0), b3);
            PG8_BAR; PG8_WAIT_L(0); PG8_MMA(0, 1, At, B1); PG8_BAR;
            PG8_LDA(At, 1, 1); PG8_STAGEA(PG8_SA(1, 0), a3);
            PG8_BAR; PG8_WAIT_L(0); PG8_MMA(1, 0, At, B0); PG8_BAR; PG8_SCHED;
            PG8_STAGEB(PG8_SB(1, 1), b3 + hstepB);
            PG8_WAIT_V(6); PG8_BAR; PG8_MMA(1, 1, At, B1); PG8_BAR;
            }
        }
#pragma unroll 1
        for (int t = PEEL ? 2 : 0; t < nt; t += 2) {
            const bool last = (t == nt - 2);
            const unsigned a1 = cA + (unsigned)(t + 1) * kstep;
            const unsigned a2 = last ? nA : cA + (unsigned)(t + 2) * kstep, b2 = last ? nB : cB + (unsigned)(t + 2) * kstep;
            const unsigned a3 = a2 + kstep, b3 = b2 + kstep;
            if (last && has_next) S.a_ready(nxt);
            if constexpr (SP2) {
            PG8_LDB(B0, 0, 0); PG8_LDB(B1, 0, 1); PG8_SCHED; PG8_LDA(At, 0, 0); PG8_STAGEA(PG8_SA(1, 1), a1 + hstepA);
            PG8_WAIT_V(8); PG8_WAIT_L(0); PG8_BAR; PG8_SCHED; PG8_MMA(0, 0, At, B0); PG8_MMA(0, 1, At, B1); PG8_BAR; PG8_SCHED;
            PG8_LDA(At, 0, 1); PG8_STAGEB(PG8_SB(0, 0), b2); PG8_STAGEB(PG8_SB(0, 1), b2 + hstepB); PG8_STAGEA(PG8_SA(0, 0), a2);
            PG8_WAIT_V(8); PG8_WAIT_L(0); PG8_BAR; PG8_SCHED; PG8_MMA(1, 0, At, B0); PG8_MMA(1, 1, At, B1); PG8_BAR; PG8_SCHED;
            PG8_LDB(B0, 1, 0); PG8_LDB(B1, 1, 1); PG8_SCHED; PG8_LDA(At, 1, 0); PG8_STAGEA(PG8_SA(0, 1), a2 + hstepA);
            PG8_WAIT_V(8); PG8_WAIT_L(0); PG8_BAR; PG8_SCHED; PG8_MMA(0, 0, At, B0); PG8_MMA(0, 1, At, B1); PG8_BAR; PG8_SCHED;
            PG8_LDA(At, 1, 1); PG8_STAGEB(PG8_SB(1, 0), b3); PG8_STAGEB(PG8_SB(1, 1), b3 + hstepB); PG8_STAGEA(PG8_SA(1, 0), a3);
            PG8_WAIT_V(8); PG8_WAIT_L(0); PG8_BAR; PG8_SCHED; PG8_MMA(1, 0, At, B0); PG8_MMA(1, 1, At, B1); PG8_BAR; PG8_SCHED;
            } else {
            PG8_LDB(B0, 0, 0); PG8_SCHED; PG8_LDA(At, 0, 0); PG8_STAGEA(PG8_SA(1, 1), a1 + hstepA);
            PG8_WAIT_L(8); PG8_BAR; PG8_WAIT_L(0); PG8_MMA(0, 0, At, B0); PG8_BAR; PG8_SCHED;
            PG8_LDB(B1, 0, 1); PG8_STAGEB(PG8_SB(0, 0), b2);
            PG8_BAR; PG8_WAIT_L(0); PG8_MMA(0, 1, At, B1); PG8_BAR;
            PG8_LDA(At, 0, 1); PG8_STAGEA(PG8_SA(0, 0), a2);
            PG8_BAR; PG8_WAIT_L(0); PG8_MMA(1, 0, At, B0); PG8_BAR; PG8_SCHED;
            PG8_STAGEB(PG8_SB(0, 1), b2 + hstepB);
            PG8_WAIT_V(6); PG8_BAR; PG8_MMA(1, 1, At, B1); PG8_BAR;
            PG8_LDB(B0, 1, 0); PG8_SCHED; PG8_LDA(At, 1, 0); PG8_STAGEA(PG8_SA(0, 1), a2 + hstepA);
            PG8_WAIT_L(8); PG8_BAR; PG8_WAIT_L(0); PG8_MMA(0, 0, At, B0); PG8_BAR; PG8_SCHED;
            PG8_LDB(B1, 1, 1); PG8_STAGEB(PG8_SB(1, 0), b3);
            PG8_BAR; PG8_WAIT_L(0); PG8_MMA(0, 1, At, B1); PG8_BAR;
            PG8_LDA(At, 1, 1); PG8_STAGEA(PG8_SA(1, 0), a3);
            PG8_BAR; PG8_WAIT_L(0); PG8_MMA(1, 0, At, B0); PG8_BAR; PG8_SCHED;
            PG8_STAGEB(PG8_SB(1, 1), b3 + hstepB);
            PG8_WAIT_V(6); PG8_BAR; PG8_MMA(1, 1, At, B1); PG8_BAR;
            }
        }
        if constexpr (ALIGN_EPI) { if (wr == 0) PG8_BAR; }
        { int fr_ = fr, fq_ = fq; asm volatile("" : "+v"(fr_), "+v"(fq_));
          E(acc, cur, wr, wc, fr_, fq_); } S.done(cur);
        if (!has_next) break;
        if constexpr (!PEEL) {
#pragma unroll
        for (int a = 0; a < 2; ++a)
#pragma unroll
            for (int b = 0; b < 2; ++b)
#pragma unroll
                for (int m = 0; m < 4; ++m)
#pragma unroll
                    for (int n = 0; n < 2; ++n) acc[a][b][m][n] = (f32x4){0.f, 0.f, 0.f, 0.f};
        }
        cur = nxt; cA = nA; cB = nB; ++ui;
        if constexpr (ALIGN_EPI) { if (wr == 1) PG8_BAR; }
    }
    PG8_WAIT_V(0);
    if constexpr (!ALIGN_EPI) { if (wr == 0) PG8_BAR; }
    PG8_BAR;
#undef PG8_SA
#undef PG8_SB
#undef PG8_STAGE_
#undef PG8_STAGEA
#undef PG8_STAGEB
#undef PG8_LDA
#undef PG8_LDB
#undef PG8_MMA
#undef PG8_MMA_
#undef PG8_MMAZ
#undef PG8_WAIT_V
#undef PG8_WAIT_L
#undef PG8_BAR
#undef PG8_SCHED
}

__device__ __forceinline__ float shx(float v, int mask, int fr, int fq) { return __builtin_bit_cast(float, __builtin_amdgcn_ds_bpermute((((fq << 4) | fr) ^ mask) << 2, __builtin_bit_cast(int, v))); }
template <int NSS> struct RowScaleT {
    const float* p; float inv_dim;
    __device__ __forceinline__ float get(int row, int fq, int fr = 0) const {
        if constexpr (NSS == 0) return p[row];
        else { constexpr int NCH = NSS / 4; const f32x4 v = *(const f32x4*)(p + (size_t)row * NSS + 4 * (fq % NCH));
            float s = (v[0] + v[1]) + (v[2] + v[3]);
            if constexpr (NCH >= 2) s += shx(s, 16, fr, fq);
            if constexpr (NCH >= 4) s += shx(s, 32, fr, fq);
            return __builtin_amdgcn_rsqf(s * inv_dim + 1e-6f); }
    }
};
template <int NSS> struct EpiScaleBf16 {
    static constexpr bool PERM = true; static constexpr unsigned WSCALE = 0x7F7F7F7Fu; static constexpr int A_AUX = 0, B_AUX = 0;
    bf16_t* O; int ldc; RowScaleT<NSS> R; int ntmod;
    __device__ __forceinline__ void operator()(const f32x4 (&acc)[2][2][4][2], const Unit& u, int wr, int wc, int fr, int fq) const {
        const int row0 = u.pm * BM + wr * 64 + fr, col0 = (u.pn % ntmod) * BM + wc * 32 + 8 * fq;
        float sc[2][4];
#pragma unroll
        for (int ai = 0; ai < 2; ++ai)
#pragma unroll
            for (int m = 0; m < 4; ++m) sc[ai][m] = R.get(row0 + ai * HALF + m * 16, fq, fr);
#pragma unroll
        for (int ai = 0; ai < 2; ++ai)
#pragma unroll
            for (int m = 0; m < 4; ++m) { const int row = row0 + ai * HALF + m * 16; const float s = sc[ai][m]; bf16_t* rowp = O + (size_t)row * ldc + col0;
#pragma unroll
                for (int bj = 0; bj < 2; ++bj) { const f32x4 v0 = acc[ai][bj][m][0] * s, v1 = acc[ai][bj][m][1] * s;
                    u32x4 w; w.x = cvt_pk_bf16(v0[0], v0[1]); w.y = cvt_pk_bf16(v0[2], v0[3]); w.z = cvt_pk_bf16(v1[0], v1[1]); w.w = cvt_pk_bf16(v1[2], v1[3]);
                    st_out(O, rowp + bj * HALF, w); } }
    }
};
__device__ __forceinline__ unsigned pk4_fp8(float a, float b, float c, float d) { unsigned w = 0u; a = __builtin_amdgcn_fmed3f(a, -448.f, 448.f); b = __builtin_amdgcn_fmed3f(b, -448.f, 448.f); c = __builtin_amdgcn_fmed3f(c, -448.f, 448.f); d = __builtin_amdgcn_fmed3f(d, -448.f, 448.f);
    w = __builtin_amdgcn_cvt_pk_fp8_f32(a, b, w, false); w = __builtin_amdgcn_cvt_pk_fp8_f32(c, d, w, true); return w; }
__device__ __forceinline__ unsigned pk4_fp8_ns(float a, float b, float c, float d) { unsigned w = 0u; w = __builtin_amdgcn_cvt_pk_fp8_f32(a, b, w, false); w = __builtin_amdgcn_cvt_pk_fp8_f32(c, d, w, true); return w; }
template <int NSS> struct EpiScaleF8 {
    static constexpr bool PERM = true; static constexpr unsigned WSCALE = 0x7F7F7F7Fu; static constexpr int A_AUX = MOE2_A_AUX, B_AUX = MOE2_B_AUX;
    unsigned char* O; int ldc; RowScaleT<NSS> R; int ntmod;
    __device__ __forceinline__ void operator()(const f32x4 (&acc)[2][2][4][2], const Unit& u, int wr, int wc, int fr, int fq) const {
        const int row0 = u.pm * BM + wr * 64 + fr, col0 = (u.pn % ntmod) * BM + wc * 32 + 8 * fq;
        float sc[2][4];
#pragma unroll
        for (int ai = 0; ai < 2; ++ai)
#pragma unroll
            for (int m = 0; m < 4; ++m) sc[ai][m] = R.get(row0 + ai * HALF + m * 16, fq, fr);
#pragma unroll
        for (int ai = 0; ai < 2; ++ai)
#pragma unroll
            for (int m = 0; m < 4; ++m) { const int row = row0 + ai * HALF + m * 16; const float s = sc[ai][m]; unsigned char* rowp = O + (size_t)row * ldc + col0;
#pragma unroll
                for (int bj = 0; bj < 2; ++bj) { const f32x4 v0 = acc[ai][bj][m][0] * s, v1 = acc[ai][bj][m][1] * s;
                    u32x2 w; w.x = pk4_fp8(v0[0], v0[1], v0[2], v0[3]); w.y = pk4_fp8(v1[0], v1[1], v1[2], v1[3]);
                    st_out(O, rowp + bj * HALF, w); } }
    }
};
struct EpiKvUp {
    static constexpr bool PERM = true; static constexpr unsigned WSCALE = 0x7F7F7F7Fu; static constexpr int A_AUX = 0, B_AUX = 0;
    bf16_t* O; int ldc; RowScaleT<4> R; const bf16_t* Z; const float* rope; const float* kg; bf16_t* KF; int seq_log2;
    __device__ __forceinline__ void operator()(const f32x4 (&acc)[2][2][4][2], const Unit& u, int wr, int wc, int fr, int fq) const {
        { const int row0 = u.pm * BM + wr * 64 + fr, col0 = u.pn * BM + wc * 32 + 8 * fq;
          float sc[2][4];
#pragma unroll
          for (int ai = 0; ai < 2; ++ai)
#pragma unroll
              for (int m = 0; m < 4; ++m) sc[ai][m] = R.get(row0 + ai * HALF + m * 16, fq, fr);
#pragma unroll
          for (int ai = 0; ai < 2; ++ai)
#pragma unroll
              for (int m = 0; m < 4; ++m) { const int row = row0 + ai * HALF + m * 16; const float s = sc[ai][m]; bf16_t* rowp = O + (size_t)row * ldc + col0;
#pragma unroll
                  for (int bj = 0; bj < 2; ++bj) { const f32x4 v0 = acc[ai][bj][m][0] * s, v1 = acc[ai][bj][m][1] * s;
                      u32x4 w; w.x = cvt_pk_bf16(v0[0], v0[1]); w.y = cvt_pk_bf16(v0[2], v0[3]); w.z = cvt_pk_bf16(v1[0], v1[1]); w.w = cvt_pk_bf16(v1[2], v1[3]);
                      *(u32x4*)(rowp + bj * HALF) = w; } } }
        asm volatile("s_waitcnt vmcnt(0)" ::: "memory"); __builtin_amdgcn_s_barrier(); asm volatile("" ::: "memory");
        typedef float f32x2 __attribute__((ext_vector_type(2)));
        const int lane = (fq << 4) | fr, wave = wr * 4 + wc, h = u.pn;
        const float gr = kg[128 + lane]; const f32x2 gn = *(const f32x2*)(kg + 2 * lane);
        unsigned wv[2][8], kv[2][8]; f32x2 cs[2][8];
#define KF_LOAD(set_, i0_) do { _Pragma("unroll") for (int q = 0; q < 8; ++q) { const size_t row = (size_t)u.pm * BM + wave * 32 + (i0_) + q; \
            wv[set_][q] = *(const unsigned*)(O + row * ldc + h * BM + 2 * lane); kv[set_][q] = (unsigned)Z[row * 1024 + 640 + lane]; cs[set_][q] = *(const f32x2*)(rope + (row * 32 + (lane & 31)) * 2); } } while (0)
        KF_LOAD(0, 0);
#pragma unroll
        for (int bt = 0; bt < 4; ++bt) { const int i0 = bt * 8, st = bt & 1;
            if (bt < 3) KF_LOAD((bt + 1) & 1, i0 + 8);
#pragma unroll
            for (int q = 0; q < 8; ++q) { const int row = u.pm * BM + wave * 32 + i0 + q, b = row >> seq_log2, sq = row & ((1 << seq_log2) - 1); const int seq = 1 << seq_log2;
                const float a = __uint_as_float(wv[st][q] << 16), c2 = __uint_as_float(wv[st][q] & 0xffff0000u), kr = __uint_as_float(kv[st][q] << 16);
                float ss = a * a + c2 * c2 + kr * kr;
                ss += __builtin_bit_cast(float, __builtin_amdgcn_update_dpp(0, __builtin_bit_cast(int, ss), 0xB1, 0xF, 0xF, true));
                ss += __builtin_bit_cast(float, __builtin_amdgcn_update_dpp(0, __builtin_bit_cast(int, ss), 0x4E, 0xF, 0xF, true));
                ss += __builtin_bit_cast(float, __builtin_amdgcn_update_dpp(0, __builtin_bit_cast(int, ss), 0x141, 0xF, 0xF, true));
                ss += __builtin_bit_cast(float, __builtin_amdgcn_update_dpp(0, __builtin_bit_cast(int, ss), 0x140, 0xF, 0xF, true));
                { auto rr = __builtin_amdgcn_permlane16_swap(__float_as_uint(ss), __float_as_uint(ss), false, false); ss = __uint_as_float(rr[0]) + __uint_as_float(rr[1]); }
                { auto rr = __builtin_amdgcn_permlane32_swap(__float_as_uint(ss), __float_as_uint(ss), false, false); ss = __uint_as_float(rr[0]) + __uint_as_float(rr[1]); }
                const float rk = 1.0f / sqrtf(ss * (1.0f / 192) + 1e-6f);
                bf16_t* ko = KF + ((size_t)(b * 6 + h) * seq + sq) * 192;
                *(unsigned*)(ko + 2 * lane) = cvt_pk_bf16(a * rk * gn.x, c2 * rk * gn.y);
                const float y = kr * rk * gr; float yp; { auto rr = __builtin_amdgcn_permlane32_swap(__float_as_uint(y), __float_as_uint(y), false, false); yp = __uint_as_float(lane < 32 ? rr[1] : rr[0]); } const float o_ = (lane < 32) ? (y * cs[st][q].x - yp * cs[st][q].y) : (y * cs[st][q].x + yp * cs[st][q].y);
                ko[128 + lane] = (bf16_t)(cvt_pk_bf16(o_, 0.f) & 0xffffu); } }
#undef KF_LOAD
    }
};
struct EpiResidual {
    static constexpr bool PERM = true; static constexpr unsigned WSCALE = 0x7F7F7F7Fu; static constexpr int A_AUX = 0, B_AUX = 0;
    const float* Xin; float* Xout; bf16_t* XB; float* SS; int ldc;
    __device__ __forceinline__ void operator()(const f32x4 (&acc)[2][2][4][2], const Unit& u, int wr, int wc, int fr, int fq) const {
        const int row0 = u.pm * BM + wr * 64 + fr, col0 = u.pn * BM + wc * 32 + 8 * fq;
#pragma unroll
        for (int ai = 0; ai < 2; ++ai)
#pragma unroll
            for (int m = 0; m < 4; ++m) { const int row = row0 + ai * HALF + m * 16; const size_t off = (size_t)row * ldc + col0; float q = 0.f;
#pragma unroll
                for (int bj = 0; bj < 2; ++bj) {
                    const f32x4 x0 = *(const f32x4*)(Xin + off + bj * HALF), x1 = *(const f32x4*)(Xin + off + bj * HALF + 4);
                    const f32x4 v0 = x0 + acc[ai][bj][m][0], v1 = x1 + acc[ai][bj][m][1];
                    *(f32x4*)(Xout + off + bj * HALF) = v0; *(f32x4*)(Xout + off + bj * HALF + 4) = v1;
                    u32x4 w; w.x = cvt_pk_bf16(v0[0], v0[1]); w.y = cvt_pk_bf16(v0[2], v0[3]); w.z = cvt_pk_bf16(v1[0], v1[1]); w.w = cvt_pk_bf16(v1[2], v1[3]);
                    *(u32x4*)(XB + off + bj * HALF) = w;
                    q += (v0[0] * v0[0] + v0[1] * v0[1]) + (v0[2] * v0[2] + v0[3] * v0[3]) + (v1[0] * v1[0] + v1[1] * v1[1]) + (v1[2] * v1[2] + v1[3] * v1[3]); }
                q += shx(q, 16, fr, fq); q += shx(q, 32, fr, fq);
                if (fq == 0) SS[(size_t)row * 16 + u.pn * 4 + wc] = q; }
    }
};
template <unsigned WS_ = 0x7F7F7F7Fu, int MB = 4, bool W8 = false> struct EpiResidualBf16T {
    static constexpr bool PERM = true; static constexpr unsigned WSCALE = WS_; static constexpr int A_AUX = 0, B_AUX = 0;
    bf16_t* XB; float* SS; int ldc; unsigned char* X8;
    __device__ __forceinline__ void operator()(const f32x4 (&acc)[2][2][4][2], const Unit& u, int wr, int wc, int fr, int fq) const {
        const int row0 = u.pm * BM + wr * 64 + fr, col0 = u.pn * BM + wc * 32 + 8 * fq;
#pragma unroll
        for (int ai = 0; ai < 2; ++ai)
#pragma unroll
          for (int mb = 0; mb < 4; mb += MB) {
            u32x4 xw[MB][2];
#pragma unroll
            for (int mm = 0; mm < MB; ++mm)
#pragma unroll
                for (int bj = 0; bj < 2; ++bj) xw[mm][bj] = *(const u32x4*)(XB + (size_t)(row0 + ai * HALF + (mb + mm) * 16) * ldc + col0 + bj * HALF);
#pragma unroll
            for (int mm = 0; mm < MB; ++mm) { const int m = mb + mm; const int row = row0 + ai * HALF + m * 16; bf16_t* rowp = XB + (size_t)row * ldc + col0; float q = 0.f;
#pragma unroll
                for (int bj = 0; bj < 2; ++bj) { float v[8];
#pragma unroll
                    for (int j = 0; j < 4; ++j) { v[2 * j] = __uint_as_float(xw[mm][bj][j] << 16) + acc[ai][bj][m][j >> 1][(2 * j) & 3]; v[2 * j + 1] = __uint_as_float(xw[mm][bj][j] & 0xffff0000u) + acc[ai][bj][m][j >> 1][(2 * j + 1) & 3]; }
                    u32x4 w; w.x = cvt_pk_bf16(v[0], v[1]); w.y = cvt_pk_bf16(v[2], v[3]); w.z = cvt_pk_bf16(v[4], v[5]); w.w = cvt_pk_bf16(v[6], v[7]);
                    st_out(XB, rowp + bj * HALF, w);
                    if constexpr (W8) { u32x2 w8; w8.x = pk4_fp8_ns(v[0], v[1], v[2], v[3]); w8.y = pk4_fp8_ns(v[4], v[5], v[6], v[7]); st_out(X8, X8 + (size_t)row * ldc + col0 + bj * HALF, w8); }
#pragma unroll
                    for (int j = 0; j < 8; ++j) q += v[j] * v[j]; }
                q += shx(q, 16, fr, fq); q += shx(q, 32, fr, fq);
                if (fq == 0) SS[(size_t)row * 16 + u.pn * 4 + wc] = q; } }
    }
};
typedef EpiResidualBf16T<> EpiResidualBf16;
template <bool F8OUT, int NSS> struct EpiSwiGLU {
    static constexpr bool PERM = true; static constexpr unsigned WSCALE = 0x7F7F7F7Fu; static constexpr int A_AUX = 0, B_AUX = 0;
    bf16_t* H; int ldh; RowScaleT<NSS> R; int ntmod; float hscale;
    __device__ __forceinline__ void operator()(const f32x4 (&acc)[2][2][4][2], const Unit& u, int wr, int wc, int fr, int fq) const {
        const int row0 = u.pm * BM + wr * 64 + fr, col0 = (u.pn % ntmod) * HALF + wc * 32 + 8 * fq;
        float sc[2][4];
#pragma unroll
        for (int ai = 0; ai < 2; ++ai)
#pragma unroll
            for (int m = 0; m < 4; ++m) sc[ai][m] = R.get(row0 + ai * HALF + m * 16, fq, fr);
#pragma unroll
        for (int ai = 0; ai < 2; ++ai)
#pragma unroll
            for (int m = 0; m < 4; ++m) { const int row = row0 + ai * HALF + m * 16; const float s = sc[ai][m];
                float h[8]; const float sneg = -1.4426950408889634f * s, s2h = s * s * hscale;
                typedef float f32x2 __attribute__((ext_vector_type(2)));
#pragma unroll
                for (int n = 0; n < 2; ++n)
#pragma unroll
                    for (int j = 0; j < 4; j += 2) { const f32x2 ag = {acc[ai][0][m][n][j], acc[ai][0][m][n][j + 1]}, au = {acc[ai][1][m][n][j], acc[ai][1][m][n][j + 1]};
                        const f32x2 t = ag * sneg; f32x2 e; e.x = __builtin_amdgcn_exp2f(t.x); e.y = __builtin_amdgcn_exp2f(t.y);
                        const f32x2 d = e + 1.0f; f32x2 r; r.x = __builtin_amdgcn_rcpf(d.x); r.y = __builtin_amdgcn_rcpf(d.y);
                        const f32x2 hh = ((ag * au) * s2h) * r; h[n * 4 + j] = hh.x; h[n * 4 + j + 1] = hh.y; }
                if constexpr (F8OUT) { u32x2 w; w.x = pk4_fp8_ns(h[0], h[1], h[2], h[3]); w.y = pk4_fp8_ns(h[4], h[5], h[6], h[7]);
                    st_out(H, (unsigned char*)H + (size_t)row * ldh + col0, w); }
                else { u32x4 w; w.x = cvt_pk_bf16(h[0], h[1]); w.y = cvt_pk_bf16(h[2], h[3]); w.z = cvt_pk_bf16(h[4], h[5]); w.w = cvt_pk_bf16(h[6], h[7]);
                    st_out(H, H + (size_t)row * ldh + col0, w); } }
    }
};
struct EpiSwiGLUFold {
    static constexpr bool PERM = true; static constexpr unsigned WSCALE = 0x79797979u; static constexpr int A_AUX = 0, B_AUX = MOE1_B_AUX;
    unsigned char* H; int ldh; int ntmod;
    __device__ __forceinline__ void operator()(const f32x4 (&acc)[2][2][4][2], const Unit& u, int wr, int wc, int fr, int fq) const {
        const int row0 = u.pm * BM + wr * 64 + fr, col0 = (u.pn % ntmod) * HALF + wc * 32 + 8 * fq;
        typedef float f32x2 __attribute__((ext_vector_type(2)));
#pragma unroll
        for (int ai = 0; ai < 2; ++ai)
#pragma unroll
            for (int m = 0; m < 4; ++m) { const int row = row0 + ai * HALF + m * 16; float h[8];
#pragma unroll
                for (int n = 0; n < 2; ++n)
#pragma unroll
                    for (int j = 0; j < 4; j += 2) { const f32x2 ag = {acc[ai][0][m][n][j], acc[ai][0][m][n][j + 1]}, au = {acc[ai][1][m][n][j], acc[ai][1][m][n][j + 1]};
                        f32x2 e; e.x = __builtin_amdgcn_exp2f(-ag.x); e.y = __builtin_amdgcn_exp2f(-ag.y);
                        const f32x2 d = e + 1.0f; f32x2 r; r.x = __builtin_amdgcn_rcpf(d.x); r.y = __builtin_amdgcn_rcpf(d.y);
                        const f32x2 hh = (ag * au) * r; h[n * 4 + j] = hh.x; h[n * 4 + j + 1] = hh.y; }
                u32x2 w; w.x = pk4_fp8_ns(h[0], h[1], h[2], h[3]); w.y = pk4_fp8_ns(h[4], h[5], h[6], h[7]);
                st_out(H, H + (size_t)row * ldh + col0, w); }
    }
};
template <unsigned WS_ = 0x7F7F7F7Fu> struct EpiInProj1T {
    static constexpr bool PERM = true; static constexpr unsigned WSCALE = WS_; static constexpr int A_AUX = 0, B_AUX = 0;
    bf16_t* Z; int ldc; RowScaleT<16> R; float* SSKV; float* SSQ;
    __device__ __forceinline__ void operator()(const f32x4 (&acc)[2][2][4][2], const Unit& u, int wr, int wc, int fr, int fq) const {
        const int row0 = u.pm * BM + wr * 64 + fr, col0 = u.pn * BM + wc * 32 + 8 * fq;
        float sc[2][4];
#pragma unroll
        for (int ai = 0; ai < 2; ++ai)
#pragma unroll
            for (int m = 0; m < 4; ++m) sc[ai][m] = R.get(row0 + ai * HALF + m * 16, fq, fr);
#pragma unroll
        for (int ai = 0; ai < 2; ++ai)
#pragma unroll
            for (int m = 0; m < 4; ++m) { const int row = row0 + ai * HALF + m * 16; const float s = sc[ai][m]; bf16_t* rowp = Z + (size_t)row * ldc + col0; float q0 = 0.f, q1 = 0.f;
#pragma unroll
                for (int bj = 0; bj < 2; ++bj) { const f32x4 v0 = acc[ai][bj][m][0] * s, v1 = acc[ai][bj][m][1] * s;
                    u32x4 w; w.x = cvt_pk_bf16(v0[0], v0[1]); w.y = cvt_pk_bf16(v0[2], v0[3]); w.z = cvt_pk_bf16(v1[0], v1[1]); w.w = cvt_pk_bf16(v1[2], v1[3]);
                    st_out(Z, rowp + bj * HALF, w);
                    const float qq = (v0[0] * v0[0] + v0[1] * v0[1]) + (v0[2] * v0[2] + v0[3] * v0[3]) + (v1[0] * v1[0] + v1[1] * v1[1]) + (v1[2] * v1[2] + v1[3] * v1[3]);
                    if (bj == 0) q0 = qq; else q1 = qq; }
                if (u.pn <= 2) {
                    float q = (u.pn == 2) ? q0 : q0 + q1;
                    q += shx(q, 16, fr, fq); q += shx(q, 32, fr, fq);
                    if (fq == 0) { if (u.pn == 0) SSKV[(size_t)row * 4 + wc] = q; else SSQ[(size_t)row * 8 + (u.pn - 1) * 4 + wc] = q; } } }
    }
};
typedef EpiInProj1T<> EpiInProj1;
}
#define LAS __attribute__((address_space(3)))
#define GAS __attribute__((address_space(1)))
typedef unsigned short bf16;
typedef short bf16x8 __attribute__((ext_vector_type(8)));
typedef short s16x4 __attribute__((ext_vector_type(4)));
typedef float f32x16 __attribute__((ext_vector_type(16)));
typedef float f32x4 __attribute__((ext_vector_type(4)));
typedef float f32x2 __attribute__((ext_vector_type(2)));
typedef unsigned u32x4 __attribute__((ext_vector_type(4)));
typedef unsigned u32x2 __attribute__((ext_vector_type(2)));
#define SBAR() __builtin_amdgcn_sched_barrier(0)
__device__ __forceinline__ unsigned cvtpk(float lo, float hi) { return pg8::cvt_pk_bf16(lo, hi); }
__device__ __forceinline__ float bf_lo(unsigned w) { return __uint_as_float(w << 16); }
__device__ __forceinline__ float bf_hi(unsigned w) { return __uint_as_float(w & 0xffff0000u); }
__device__ __forceinline__ int crow(int r, int hi) { return (r & 3) + 8 * (r >> 2) + 4 * hi; }
__device__ __forceinline__ float swap_max(float v) { auto rr = __builtin_amdgcn_permlane32_swap(__float_as_uint(v), __float_as_uint(v), false, false); return fmaxf(__uint_as_float(rr[0]), __uint_as_float(rr[1])); }
__device__ __forceinline__ float swap_add(float v) { auto rr = __builtin_amdgcn_permlane32_swap(__float_as_uint(v), __float_as_uint(v), false, false); return __uint_as_float(rr[0]) + __uint_as_float(rr[1]); }
#define PK4(P, B_, OUT) do { unsigned a0 = cvtpk(P[B_+0], P[B_+1]), a1 = cvtpk(P[B_+2], P[B_+3]);                          \
        unsigned b0 = cvtpk(P[B_+4], P[B_+5]), b1 = cvtpk(P[B_+6], P[B_+7]);                                             \
        auto r0 = __builtin_amdgcn_permlane32_swap(a0, b0, false, false); auto r1 = __builtin_amdgcn_permlane32_swap(a1, b1, false, false); \
        u32x4 w = {r0[0], r1[0], r0[1], r1[1]}; OUT = *reinterpret_cast<bf16x8*>(&w); } while (0)
template <int NCB> __device__ __forceinline__ int v_st(int k, int c) { const int kk = (k & ~0xC) | ((k & 4) << 1) | ((k & 8) >> 1); return ((kk >> 3) * NCB + (c >> 5)) * 512 + ((kk & 7) * 32 + (c & 31)) * 2; }
__device__ __forceinline__ int v_rd_base(int lane) { return ((lane & 3) << 3) | (((lane >> 2) & 3) << 6) | (((lane >> 4) & 1) << 5) | (((lane >> 5) & 1) << 8); }
#define TRRD(dst, addr, off) asm volatile("ds_read_b64_tr_b16 %0, %1 offset:%2" : "=&v"(dst) : "v"(addr), "i"(off) : "memory")

#ifndef ATT_PRIO
#define ATT_PRIO 0
#endif
#ifndef ATT_WSKIP
#define ATT_WSKIP 1
#endif
template <int DQ, int DV> struct AttGeo {
    static constexpr int KROWB = DQ * 2 + 16, KBYTES = 64 * KROWB, NCB = DV / 32, VBYTES = 64 * DV * 2, V0 = 2 * KBYTES, TOTAL = 2 * KBYTES + 2 * VBYTES;
};
template <int DQ, int DV, bool CAUSAL, bool KNORM, bool ROPE, bool F8O = false>
__device__ __forceinline__ void attn_unit(int tid, LAS unsigned char* lds, const bf16* Qp, int ldq, const bf16* Kp, int ldk, const bf16* Vp, int ldv, bf16* Op, int ldo,
                                          int NT, int q0, const float* qg, const float* kg, float qscale, const f32x2* rope) {
    typedef AttGeo<DQ, DV> G;
    asm volatile("" : "+v"(tid));
    constexpr int NQ = DQ / 16, NDB = DV / 32, NCB = G::NCB, KCH = DQ / 8, VCH = DV / 8, NKP = 64 * KCH / 512, NVP = 64 * VCH / 512;
    static_assert(NKP * 512 == 64 * KCH && NVP * 512 == 64 * VCH, "staging geometry");
    const int wid = __builtin_amdgcn_readfirstlane(tid >> 6), lane = tid & 63, r32 = lane & 31, hi = lane >> 5;
    bf16x8 qr[NQ];
    { const bf16* qrow = Qp + (size_t)(wid * 32 + r32) * ldq + hi * 8;
      float ss = 0.f;
#pragma unroll
      for (int d0 = 0; d0 < NQ; ++d0) { qr[d0] = *(const bf16x8*)(qrow + d0 * 16); const u32x4 w = *reinterpret_cast<const u32x4*>(&qr[d0]);
#pragma unroll
          for (int j = 0; j < 4; ++j) { const float a = bf_lo(w[j]), b = bf_hi(w[j]); ss += a * a + b * b; } }
      ss = swap_add(ss);
      const float rq = qscale / sqrtf(ss * (1.0f / DQ) + 1e-6f);
      constexpr int NPLAIN = ROPE ? NQ - 4 : NQ;
#pragma unroll
      for (int d0 = 0; d0 < NPLAIN; ++d0) { const u32x4 w = *reinterpret_cast<const u32x4*>(&qr[d0]); const f32x4 g0 = *(const f32x4*)(qg + d0 * 16 + hi * 8), g1 = *(const f32x4*)(qg + d0 * 16 + hi * 8 + 4);
          u32x4 o; o.x = cvtpk(bf_lo(w.x) * rq * g0[0], bf_hi(w.x) * rq * g0[1]); o.y = cvtpk(bf_lo(w.y) * rq * g0[2], bf_hi(w.y) * rq * g0[3]);
          o.z = cvtpk(bf_lo(w.z) * rq * g1[0], bf_hi(w.z) * rq * g1[1]); o.w = cvtpk(bf_lo(w.w) * rq * g1[2], bf_hi(w.w) * rq * g1[3]); qr[d0] = *reinterpret_cast<bf16x8*>(&o); }
      if constexpr (ROPE) {
#pragma unroll
          for (int pp = 0; pp < 2; ++pp) { const int da = NQ - 4 + pp, db = NQ - 2 + pp;
              const u32x4 wa = *reinterpret_cast<const u32x4*>(&qr[da]), wb = *reinterpret_cast<const u32x4*>(&qr[db]);
              float xa[8], xb[8];
#pragma unroll
              for (int j = 0; j < 4; ++j) { xa[2 * j] = bf_lo(wa[j]); xa[2 * j + 1] = bf_hi(wa[j]); xb[2 * j] = bf_lo(wb[j]); xb[2 * j + 1] = bf_hi(wb[j]); }
              const float* ga = qg + da * 16 + hi * 8; const float* gb = qg + db * 16 + hi * 8;
              const f32x2* rp = rope + (size_t)(wid * 32 + r32) * 32 + pp * 16 + hi * 8;
              float ya[8], yb[8];
#pragma unroll
              for (int j = 0; j < 8; ++j) { const float x1 = xa[j] * rq * ga[j], x2 = xb[j] * rq * gb[j]; const f32x2 cs = rp[j]; ya[j] = x1 * cs.x - x2 * cs.y; yb[j] = x2 * cs.x + x1 * cs.y; }
              u32x4 oa, ob;
#pragma unroll
              for (int j = 0; j < 4; ++j) { oa[j] = cvtpk(ya[2 * j], ya[2 * j + 1]); ob[j] = cvtpk(yb[2 * j], yb[2 * j + 1]); }
              qr[da] = *reinterpret_cast<bf16x8*>(&oa); qr[db] = *reinterpret_cast<bf16x8*>(&ob); }
      }
    }
    bf16x8 kst[NKP], vst[NVP];
#define ATT_LOADT(j_) do { _Pragma("unroll") for (int i_ = 0; i_ < NKP; ++i_) { const int p_ = tid + 512 * i_, row_ = p_ / KCH, ch_ = p_ % KCH; kst[i_] = *(const bf16x8*)(Kp + (size_t)((j_) * 64 + row_) * ldk + ch_ * 8); } \
        _Pragma("unroll") for (int i_ = 0; i_ < NVP; ++i_) { const int p_ = tid + 512 * i_, row_ = p_ / VCH, ch_ = p_ % VCH; vst[i_] = *(const bf16x8*)(Vp + (size_t)((j_) * 64 + row_) * ldv + ch_ * 8); } } while (0)
#define ATT_WRITET(buf_) do { _Pragma("unroll") for (int i_ = 0; i_ < NKP; ++i_) { const int p_ = tid + 512 * i_, row_ = p_ / KCH, ch_ = p_ % KCH; bf16x8 kv_ = kst[i_]; \
            if constexpr (KNORM) { const u32x4 w_ = *reinterpret_cast<const u32x4*>(&kv_); float f_[8]; float s_ = 0.f; \
                _Pragma("unroll") for (int j_ = 0; j_ < 4; ++j_) { f_[2 * j_] = bf_lo(w_[j_]); f_[2 * j_ + 1] = bf_hi(w_[j_]); s_ += f_[2 * j_] * f_[2 * j_] + f_[2 * j_ + 1] * f_[2 * j_ + 1]; } \
                s_ += __shfl_xor(s_, 1); s_ += __shfl_xor(s_, 2); s_ += __shfl_xor(s_, 4); const float rk_ = 1.0f / sqrtf(s_ * (1.0f / DQ) + 1e-6f); \
                const f32x4 g0_ = *(const f32x4*)(kg + ch_ * 8), g1_ = *(const f32x4*)(kg + ch_ * 8 + 4); u32x4 o_; \
                o_.x = cvtpk(f_[0] * rk_ * g0_[0], f_[1] * rk_ * g0_[1]); o_.y = cvtpk(f_[2] * rk_ * g0_[2], f_[3] * rk_ * g0_[3]); o_.z = cvtpk(f_[4] * rk_ * g1_[0], f_[5] * rk_ * g1_[1]); o_.w = cvtpk(f_[6] * rk_ * g1_[2], f_[7] * rk_ * g1_[3]); \
                kv_ = *reinterpret_cast<bf16x8*>(&o_); } \
            *(LAS bf16x8*)(lds + (buf_) * G::KBYTES + row_ * G::KROWB + ch_ * 16) = kv_; } \
        _Pragma("unroll") for (int i_ = 0; i_ < NVP; ++i_) { const int p_ = tid + 512 * i_, row_ = p_ / VCH, ch_ = p_ % VCH; *(LAS bf16x8*)(lds + G::V0 + (buf_) * G::VBYTES + v_st<NCB>(row_, ch_ * 8)) = vst[i_]; } } while (0)
    static_assert(!KNORM || KCH == 8, "KNORM reduces over 8 consecutive lanes");
    ATT_LOADT(0); ATT_WRITET(0); if (NT > 1) ATT_LOADT(1);
    __syncthreads();
    float m_reg = -1e30f, l_reg = 0.f; f32x16 o[NDB];
#pragma unroll
    for (int d = 0; d < NDB; ++d) o[d] = f32x16{};
    const unsigned vb0 = (unsigned)(uintptr_t)(lds + G::V0) + (unsigned)v_rd_base(lane);
    const int qfirst = q0 + wid * 32, qrow = qfirst + r32;
    for (int j = 0; j < NT; ++j) {
        const int buf = j & 1;
        if (j + 1 < NT) { ATT_WRITET(buf ^ 1); if (j + 2 < NT) ATT_LOADT(j + 2); }
        const bool act = !ATT_WSKIP || !CAUSAL || (64 * j <= qfirst + 31);
        if (act) {
            f32x16 p0 = f32x16{}, p1 = f32x16{};
            const LAS unsigned char* kb = lds + buf * G::KBYTES + r32 * G::KROWB + hi * 16;
#pragma unroll
            for (int d0 = 0; d0 < NQ; ++d0) { const bf16x8 a0 = *(const LAS bf16x8*)(kb + d0 * 32), a1 = *(const LAS bf16x8*)(kb + 32 * G::KROWB + d0 * 32);
                p0 = __builtin_amdgcn_mfma_f32_32x32x16_bf16(a0, qr[d0], p0, 0, 0, 0); p1 = __builtin_amdgcn_mfma_f32_32x32x16_bf16(a1, qr[d0], p1, 0, 0, 0); }
            if (CAUSAL && (64 * j + 63 > qfirst)) { const float NEG = -__builtin_inff(); const int dq = qrow - 64 * j - 4 * hi;
#pragma unroll
                for (int r = 0; r < 16; ++r) { const int c = (r & 3) + 8 * (r >> 2); if (c > dq) p0[r] = NEG; if (c + 32 > dq) p1[r] = NEG; } }
            float pmax = p0[0];
#pragma unroll
            for (int r = 1; r < 16; ++r) pmax = fmaxf(pmax, p0[r]);
#pragma unroll
            for (int r = 0; r < 16; ++r) pmax = fmaxf(pmax, p1[r]);
            pmax = swap_max(pmax);
            float mn, alpha;
            if (__all(pmax - m_reg <= 11.5f)) { mn = m_reg; alpha = 1.f; }
            else { mn = fmaxf(m_reg, pmax); alpha = __builtin_amdgcn_exp2f(m_reg - mn); m_reg = mn; }
            float ps = 0.f;
#pragma unroll
            for (int r = 0; r < 16; ++r) { p0[r] = __builtin_amdgcn_exp2f(p0[r] - mn); p1[r] = __builtin_amdgcn_exp2f(p1[r] - mn); ps += p0[r] + p1[r]; }
            ps = swap_add(ps);
            l_reg = l_reg * alpha + ps;
            if (__any(alpha < 1.f)) {
#pragma unroll
                for (int d = 0; d < NDB; ++d)
#pragma unroll
                    for (int r = 0; r < 16; ++r) o[d][r] *= alpha; }
            bf16x8 pa0, pa1, pa2, pa3;
            PK4(p0, 0, pa0); PK4(p0, 8, pa1); PK4(p1, 0, pa2); PK4(p1, 8, pa3);
            const unsigned vb = vb0 + (unsigned)(buf * G::VBYTES);
#pragma unroll
            for (int d0 = 0; d0 < NDB; ++d0) { s16x4 l0, l1, l2, l3, h0, h1, h2, h3;
                TRRD(l0, vb, d0 * 512 + 0 * NCB * 1024); TRRD(h0, vb, d0 * 512 + 0 * NCB * 1024 + NCB * 512);
                TRRD(l1, vb, d0 * 512 + 1 * NCB * 1024); TRRD(h1, vb, d0 * 512 + 1 * NCB * 1024 + NCB * 512);
                TRRD(l2, vb, d0 * 512 + 2 * NCB * 1024); TRRD(h2, vb, d0 * 512 + 2 * NCB * 1024 + NCB * 512);
                TRRD(l3, vb, d0 * 512 + 3 * NCB * 1024); TRRD(h3, vb, d0 * 512 + 3 * NCB * 1024 + NCB * 512);
                asm volatile("s_waitcnt lgkmcnt(0)" ::: "memory"); SBAR();
                o[d0] = __builtin_amdgcn_mfma_f32_32x32x16_bf16((bf16x8){l0[0], l0[1], l0[2], l0[3], h0[0], h0[1], h0[2], h0[3]}, pa0, o[d0], 0, 0, 0);
                o[d0] = __builtin_amdgcn_mfma_f32_32x32x16_bf16((bf16x8){l1[0], l1[1], l1[2], l1[3], h1[0], h1[1], h1[2], h1[3]}, pa1, o[d0], 0, 0, 0);
                o[d0] = __builtin_amdgcn_mfma_f32_32x32x16_bf16((bf16x8){l2[0], l2[1], l2[2], l2[3], h2[0], h2[1], h2[2], h2[3]}, pa2, o[d0], 0, 0, 0);
                o[d0] = __builtin_amdgcn_mfma_f32_32x32x16_bf16((bf16x8){l3[0], l3[1], l3[2], l3[3], h3[0], h3[1], h3[2], h3[3]}, pa3, o[d0], 0, 0, 0); }
        }
        asm volatile("s_waitcnt lgkmcnt(0)" ::: "memory"); __builtin_amdgcn_s_barrier(); asm volatile("" ::: "memory");
    }
#undef ATT_LOADT
#undef ATT_WRITET
    const float rl = 1.0f / l_reg;
    if constexpr (F8O) { unsigned char* orow8 = (unsigned char*)Op + (size_t)(wid * 32 + r32) * ldo + 4 * hi;
#pragma unroll
        for (int d0 = 0; d0 < NDB; ++d0)
#pragma unroll
            for (int g4 = 0; g4 < 4; ++g4) *(unsigned*)(orow8 + d0 * 32 + 8 * g4) = pg8::pk4_fp8(o[d0][4 * g4] * rl, o[d0][4 * g4 + 1] * rl, o[d0][4 * g4 + 2] * rl, o[d0][4 * g4 + 3] * rl); }
    else {
    bf16* orow = Op + (size_t)(wid * 32 + r32) * ldo + 4 * hi;
#pragma unroll
    for (int d0 = 0; d0 < NDB; ++d0)
#pragma unroll
        for (int g4 = 0; g4 < 4; ++g4) { u32x2 w; w.x = cvtpk(o[d0][4 * g4] * rl, o[d0][4 * g4 + 1] * rl); w.y = cvtpk(o[d0][4 * g4 + 2] * rl, o[d0][4 * g4 + 3] * rl);
            *(u32x2*)(orow + d0 * 32 + 8 * g4) = w; } }
    __syncthreads();
}
#ifndef ML_SCAN8
#define ML_SCAN8 0
#endif
#ifndef ML_GATE_WAVE
#define ML_GATE_WAVE 1
#endif
#ifndef ML_WIDE_ST
#define ML_WIDE_ST 1
#endif
#ifndef ML_TFAST
#define ML_TFAST 1
#endif
constexpr int ML_H = 4, ML_DK = 96, ML_DV = 192, ML_L = 64, ML_NC = 32, ML_CROWS = 224;
constexpr int ML_P0LD = 2560, ML_QOFF = 0, ML_KOFF = 384, ML_VOFF = 768, ML_OOFF = 1536;
constexpr int ML_TROW = 144;
__device__ __forceinline__ float wave_incl_sum(float v, int) {
    v += __builtin_bit_cast(float, __builtin_amdgcn_update_dpp(0, __builtin_bit_cast(int, v), 0x111, 0xF, 0xF, true));
    v += __builtin_bit_cast(float, __builtin_amdgcn_update_dpp(0, __builtin_bit_cast(int, v), 0x112, 0xF, 0xF, true));
    v += __builtin_bit_cast(float, __builtin_amdgcn_update_dpp(0, __builtin_bit_cast(int, v), 0x114, 0xF, 0xF, true));
    v += __builtin_bit_cast(float, __builtin_amdgcn_update_dpp(0, __builtin_bit_cast(int, v), 0x118, 0xF, 0xF, true));
    v += __builtin_bit_cast(float, __builtin_amdgcn_update_dpp(0, __builtin_bit_cast(int, v), 0x142, 0xA, 0xF, false));
    v += __builtin_bit_cast(float, __builtin_amdgcn_update_dpp(0, __builtin_bit_cast(int, v), 0x143, 0xC, 0xF, false));
    return v;
}
__device__ __forceinline__ float wave_incl_max(float v, int) {
    const int NI = (int)0xff800000u;
    v = fmaxf(v, __builtin_bit_cast(float, __builtin_amdgcn_update_dpp(NI, __builtin_bit_cast(int, v), 0x111, 0xF, 0xF, false)));
    v = fmaxf(v, __builtin_bit_cast(float, __builtin_amdgcn_update_dpp(NI, __builtin_bit_cast(int, v), 0x112, 0xF, 0xF, false)));
    v = fmaxf(v, __builtin_bit_cast(float, __builtin_amdgcn_update_dpp(NI, __builtin_bit_cast(int, v), 0x114, 0xF, 0xF, false)));
    v = fmaxf(v, __builtin_bit_cast(float, __builtin_amdgcn_update_dpp(NI, __builtin_bit_cast(int, v), 0x118, 0xF, 0xF, false)));
    v = fmaxf(v, __builtin_bit_cast(float, __builtin_amdgcn_update_dpp(NI, __builtin_bit_cast(int, v), 0x142, 0xA, 0xF, false)));
    v = fmaxf(v, __builtin_bit_cast(float, __builtin_amdgcn_update_dpp(NI, __builtin_bit_cast(int, v), 0x143, 0xC, 0xF, false)));
    return v;
}
__device__ __forceinline__ float wave_max(float v) {
#pragma unroll
    for (int o = 1; o < 64; o <<= 1) v = fmaxf(v, __shfl_xor(v, o));
    return v;
}
__device__ __forceinline__ float wave_sum(float v) {
    v += __builtin_bit_cast(float, __builtin_amdgcn_update_dpp(0, __builtin_bit_cast(int, v), 0xB1, 0xF, 0xF, true));
    v += __builtin_bit_cast(float, __builtin_amdgcn_update_dpp(0, __builtin_bit_cast(int, v), 0x4E, 0xF, 0xF, true));
    v += __builtin_bit_cast(float, __builtin_amdgcn_update_dpp(0, __builtin_bit_cast(int, v), 0x141, 0xF, 0xF, true));
    v += __builtin_bit_cast(float, __builtin_amdgcn_update_dpp(0, __builtin_bit_cast(int, v), 0x140, 0xF, 0xF, true));
    { auto rr = __builtin_amdgcn_permlane16_swap(__float_as_uint(v), __float_as_uint(v), false, false); v = __uint_as_float(rr[0]) + __uint_as_float(rr[1]); }
    { auto rr = __builtin_amdgcn_permlane32_swap(__float_as_uint(v), __float_as_uint(v), false, false); v = __uint_as_float(rr[0]) + __uint_as_float(rr[1]); }
    return v;
}
__device__ __forceinline__ float log_sigmoid(float x) { return fminf(x, 0.f) - log1pf(expf(-fabsf(x))); }
__device__ __forceinline__ void tr_store8(LAS unsigned char* base, int col, int t, const u32x4 w) {
#pragma unroll
    for (int j = 0; j < 4; ++j) { *(LAS unsigned short*)(base + (col + 2 * j) * ML_TROW + t * 2) = (unsigned short)(w[j] & 0xffffu); *(LAS unsigned short*)(base + (col + 2 * j + 1) * ML_TROW + t * 2) = (unsigned short)(w[j] >> 16); }
}
__device__ __forceinline__ void mlstm_a_wg(int tid, LAS unsigned char* lds, int first, int stride, int nchunks, const bf16* PROJ0, const float* IFG, bf16* CLOC, float* GLML) {
    asm volatile("" : "+v"(tid));
    const int wid = __builtin_amdgcn_readfirstlane(tid >> 6), lane = tid & 63, r32 = lane & 31, hi = lane >> 5;
    LAS unsigned char* vT = lds; LAS unsigned char* kT = lds + 32768; LAS float* el = (LAS float*)(lds + 49152);
    if (first >= nchunks) return;
    for (int p = tid; p < 32 * 64; p += 512) { const int r = 192 + (p >> 6), t = p & 63; *(LAS unsigned short*)(vT + r * ML_TROW + t * 2) = (r == 192) ? (unsigned short)0x3F80u : (unsigned short)0u; }
    u32x4 kq[2], vq[3]; float ig = 0.f, fp = 0.f;
#if ML_TFAST
    const int kt[2] = {tid % 64, (tid + 512) % 64}, kc_[2] = {tid / 64, (tid + 512) / 64};
    const int vt[3] = {tid % 64, (tid + 512) % 64, (tid + 1024) % 64}, vc[3] = {tid / 64, (tid + 512) / 64, (tid + 1024) / 64};
#else
    const int kt[2] = {tid / 12, (tid + 512) / 12}, kc_[2] = {tid % 12, (tid + 512) % 12};
    const int vt[3] = {tid / 24, (tid + 512) / 24, (tid + 1024) / 24}, vc[3] = {tid % 24, (tid + 512) % 24, (tid + 1024) % 24};
#endif
#define MLA_LOAD(cid_) do { const int bh_ = (cid_) >> 5, c_ = (cid_) & 31, h_ = bh_ & 3, tok0_ = (bh_ >> 2) * 2048 + c_ * 64; \
        kq[0] = *(const u32x4*)(PROJ0 + (size_t)(tok0_ + kt[0]) * ML_P0LD + ML_KOFF + h_ * ML_DK + kc_[0] * 8); \
        if (tid < 256) kq[1] = *(const u32x4*)(PROJ0 + (size_t)(tok0_ + kt[1]) * ML_P0LD + ML_KOFF + h_ * ML_DK + kc_[1] * 8); \
        _Pragma("unroll") for (int i_ = 0; i_ < 3; ++i_) vq[i_] = *(const u32x4*)(PROJ0 + (size_t)(tok0_ + vt[i_]) * ML_P0LD + ML_VOFF + h_ * ML_DV + vc[i_] * 8); \
        if (wid == 0) { ig = IFG[(size_t)(tok0_ + lane) * 8 + h_]; fp = IFG[(size_t)(tok0_ + lane) * 8 + 4 + h_]; } } while (0)
#define MLA_LBAR() do { asm volatile("s_waitcnt lgkmcnt(0)" ::: "memory"); __builtin_amdgcn_s_barrier(); asm volatile("" ::: "memory"); } while (0)
#define MLA_GATES(cid_, elb_) do { const float g = wave_incl_sum(log_sigmoid(fp), lane), gl = __shfl(g, 63); \
            const float w = gl - g + ig, ml = wave_max(w); \
            (elb_)[lane] = expf(w - ml) * 0.10206207261596575f;                   \
            if (lane == 0) { GLML[(cid_) * 2] = gl; GLML[(cid_) * 2 + 1] = ml; } } while (0)
    MLA_LOAD(first);
#if ML_GATE_WAVE
    if (wid == 0) MLA_GATES(first, el);
    int eb_ = 0;
#endif
    for (int cid = first; cid < nchunks; cid += stride) {
#if ML_GATE_WAVE
        LAS float* elc = el + 64 * eb_; eb_ ^= 1;
#else
        LAS float* elc = el;
        if (wid == 0) MLA_GATES(cid, el);
#endif
        MLA_LBAR();
#pragma unroll
        for (int i = 0; i < 2; ++i) if (i == 0 || tid < 256) { const float e = elc[kt[i]]; u32x4 o;
#pragma unroll
            for (int j = 0; j < 4; ++j) o[j] = cvtpk(bf_lo(kq[i][j]) * e, bf_hi(kq[i][j]) * e);
            tr_store8(kT, kc_[i] * 8, kt[i], o); }
#pragma unroll
        for (int i = 0; i < 3; ++i) tr_store8(vT, vc[i] * 8, vt[i], vq[i]);
        if (cid + stride < nchunks) MLA_LOAD(cid + stride);
        MLA_LBAR();
        bf16* Cout = CLOC + (size_t)cid * ML_CROWS * ML_DK;
#if ML_GATE_WAVE
        if (wid == 0) { if (cid + stride < nchunks) MLA_GATES(cid + stride, el + 64 * eb_); }
        else
        for (int tile = wid - 1; tile < 21; tile += 7) { const int db = tile / 3, eb = tile % 3;
#else
        for (int tile = wid; tile < 21; tile += 8) { const int db = tile / 3, eb = tile % 3;
#endif
            f32x16 acc = f32x16{};
#pragma unroll
            for (int ks = 0; ks < 4; ++ks) { const bf16x8 a = *(const LAS bf16x8*)(vT + (db * 32 + r32) * ML_TROW + (ks * 16 + hi * 8) * 2), bb = *(const LAS bf16x8*)(kT + (eb * 32 + r32) * ML_TROW + (ks * 16 + hi * 8) * 2);
                acc = __builtin_amdgcn_mfma_f32_32x32x16_bf16(a, bb, acc, 0, 0, 0); }
#if ML_WIDE_ST
            { LAS unsigned char* wsc = lds + 53248 + wid * 2560;
#pragma unroll
              for (int r = 0; r < 16; ++r) *(LAS unsigned short*)(wsc + crow(r, hi) * 80 + r32 * 2) = (unsigned short)(cvtpk(acc[r], 0.f) & 0xffffu);
              const int row = lane >> 1, half = lane & 1;
              const u32x4 w0 = *(const LAS u32x4*)(wsc + row * 80 + half * 32), w1 = *(const LAS u32x4*)(wsc + row * 80 + half * 32 + 16);
              bf16* op = Cout + (size_t)(db * 32 + row) * ML_DK + eb * 32 + half * 16;
              *(u32x4*)op = w0; *(u32x4*)(op + 8) = w1; } }
#else
#pragma unroll
            for (int r = 0; r < 16; ++r) { const int d = db * 32 + crow(r, hi); Cout[(size_t)d * ML_DK + eb * 32 + r32] = (bf16)(cvtpk(acc[r], 0.f) & 0xffffu); } }
#endif
#if !ML_GATE_WAVE
        MLA_LBAR();
#endif
    }
#if ML_GATE_WAVE
    MLA_LBAR();
#endif
#undef MLA_GATES
#undef MLA_LOAD
#undef MLA_LBAR
}
__device__ __forceinline__ void mlstm_b_item(int tid, int wi, const bf16* CLOC, bf16* CPREV, const float* GLML, float* MPREV) {
    asm volatile("" : "+v"(tid));
#if ML_SCAN8
    const int bh = wi >> 3, part = wi & 7, grp = part * 290 + tid; const bool on = tid < 290 && grp < 2316;
#else
    const int bh = wi / 5, part = wi % 5, grp = part * 512 + tid; const bool on = grp < 2316;
#endif
    float C8[8];
#pragma unroll
    for (int j = 0; j < 8; ++j) C8[j] = 0.f;
    const size_t cstride = (size_t)ML_CROWS * ML_DK;
    const bf16* src = CLOC + (size_t)bh * 32 * cstride + (size_t)grp * 8; bf16* dst = CPREV + (size_t)bh * 32 * cstride + (size_t)grp * 8;
    float ca = 0.f, cb = 0.f, cm = 0.f;
    { const int lc = tid & 31; const float glv = GLML[(bh * 32 + lc) * 2], mlv = GLML[(bh * 32 + lc) * 2 + 1]; float m = 0.f;
#pragma unroll
      for (int c = 0; c < ML_NC; ++c) { const float gl = __uint_as_float(__builtin_amdgcn_readlane(__float_as_uint(glv), c)), ml = __uint_as_float(__builtin_amdgcn_readlane(__float_as_uint(mlv), c));
          const float mn = fmaxf(gl + m, ml), a = expf(gl + m - mn), bb = expf(ml - mn);
          if (lc == c) { ca = a; cb = bb; cm = m; }
          m = mn; }
      if (part == 0 && tid < 32) MPREV[bh * 32 + tid] = cm; }
#pragma unroll
    for (int c0 = 0; c0 < ML_NC; c0 += 16) {
        u32x4 cl[16];
#pragma unroll
        for (int i = 0; i < 16; ++i) cl[i] = on ? __builtin_nontemporal_load((const u32x4*)(src + (size_t)(c0 + i) * cstride)) : (u32x4){0u, 0u, 0u, 0u};
#pragma unroll
        for (int i = 0; i < 16; ++i) { const int c = c0 + i;
            if (on) { u32x4 o; o.x = cvtpk(C8[0], C8[1]); o.y = cvtpk(C8[2], C8[3]); o.z = cvtpk(C8[4], C8[5]); o.w = cvtpk(C8[6], C8[7]); *(u32x4*)(dst + (size_t)c * cstride) = o; }
            const float a = __uint_as_float(__builtin_amdgcn_readlane(__float_as_uint(ca), c)), bb = __uint_as_float(__builtin_amdgcn_readlane(__float_as_uint(cb), c));
#pragma unroll
            for (int j = 0; j < 4; ++j) { C8[2 * j] = a * C8[2 * j] + bb * bf_lo(cl[i][j]); C8[2 * j + 1] = a * C8[2 * j + 1] + bb * bf_hi(cl[i][j]); } }
    }
}
constexpr int ML_VTB = 200 * ML_TROW;
__device__ __forceinline__ void mlstm_c_group(int tid, LAS unsigned char* lds, int cid0, const bf16* PROJ0, const float* IFG, const bf16* CPREV, const float* MPREV, const float* head_g, bf16* MIX) {
    asm volatile("" : "+v"(tid));
    const int wid = __builtin_amdgcn_readfirstlane(tid >> 6), lane = tid & 63, r32 = lane & 31, hi = lane >> 5;
    const int cw = wid >> 1, rb = wid & 1, cid = cid0 + cw, bh = cid >> 5, c = cid & 31, b = bh >> 2, h = bh & 3, tok0 = b * 2048 + c * 64;
    const int tr = rb * 32 + r32;
    const float ig = IFG[(size_t)(tok0 + lane) * 8 + h], fp = IFG[(size_t)(tok0 + lane) * 8 + 4 + h], mprev = MPREV[cid];
    const bf16* qrow = PROJ0 + (size_t)(tok0 + tr) * ML_P0LD + ML_QOFF + h * ML_DK + hi * 8;
    bf16x8 qr[6], ka0[6], ka1[6];
    { const bf16* k0 = PROJ0 + (size_t)(tok0 + r32) * ML_P0LD + ML_KOFF + h * ML_DK + hi * 8; const bf16* k1 = k0 + (size_t)32 * ML_P0LD;
#pragma unroll
      for (int d0 = 0; d0 < 6; ++d0) { qr[d0] = *(const bf16x8*)(qrow + d0 * 16); ka0[d0] = *(const bf16x8*)(k0 + d0 * 16); ka1[d0] = *(const bf16x8*)(k1 + d0 * 16); } }
#pragma unroll
    for (int i = 0; i < 12; ++i) { const int p = tid + 512 * i, ck = p / 1536, rem = p % 1536, t = ML_TFAST ? rem % 64 : rem / 24, ch = ML_TFAST ? rem / 64 : rem % 24;
        const int cid_ = cid0 + ck, bh_ = cid_ >> 5, c_ = cid_ & 31, tok = (bh_ >> 2) * 2048 + c_ * 64 + t;
        const u32x4 w = *(const u32x4*)(PROJ0 + (size_t)tok * ML_P0LD + ML_VOFF + (bh_ & 3) * ML_DV + ch * 8);
        tr_store8(lds + ck * ML_VTB, ch * 8, t, w); }
    if (tid < 256) *(LAS unsigned short*)(lds + (tid >> 6) * ML_VTB + 192 * ML_TROW + (tid & 63) * 2) = (unsigned short)0x3F80u;
    __syncthreads();
    const LAS unsigned char* vT = lds + cw * ML_VTB;
    const bf16* Cp = CPREV + (size_t)cid * ML_CROWS * ML_DK + (size_t)r32 * ML_DK + hi * 8;
    bf16x8 cp6[6], cpb[3][6];
#pragma unroll
    for (int d0 = 0; d0 < 6; ++d0) { cp6[d0] = *(const bf16x8*)(Cp + (size_t)6 * 32 * ML_DK + d0 * 16); cpb[0][d0] = *(const bf16x8*)(Cp + d0 * 16); cpb[1][d0] = *(const bf16x8*)(Cp + (size_t)32 * ML_DK + d0 * 16); }
    const float g = wave_incl_sum(log_sigmoid(fp), lane), bq = ig - g, bmax = wave_incl_max(bq, lane);
    const float gT = __shfl(g, tr), bmT = __shfl(bmax, tr), mt = gT + fmaxf(mprev, bmT), inter = expf(gT + mprev - mt), gm = gT - mt;
    f32x16 p0 = f32x16{}, p1 = f32x16{};
#pragma unroll
    for (int d0 = 0; d0 < 6; ++d0) { p0 = __builtin_amdgcn_mfma_f32_32x32x16_bf16(ka0[d0], qr[d0], p0, 0, 0, 0); p1 = __builtin_amdgcn_mfma_f32_32x32x16_bf16(ka1[d0], qr[d0], p1, 0, 0, 0); }
    LAS float* bqt = (LAS float*)(lds + 4 * ML_VTB) + wid * 64;
    bqt[lane] = bq;
    asm volatile("s_waitcnt lgkmcnt(0)" ::: "memory");
    const LAS float* bqr = bqt + 4 * hi;
#pragma unroll
    for (int r = 0; r < 16; ++r) { const int s0 = crow(r, hi), s1 = s0 + 32; const float b0 = bqr[(r & 3) + 8 * (r >> 2)], b1 = bqr[32 + (r & 3) + 8 * (r >> 2)];
        p0[r] = (s0 <= tr) ? __builtin_amdgcn_exp2f((gm + b0) * 1.4426950408889634f) * p0[r] * 0.10206207261596575f : 0.f;
        p1[r] = (s1 <= tr) ? __builtin_amdgcn_exp2f((gm + b1) * 1.4426950408889634f) * p1[r] * 0.10206207261596575f : 0.f; }
    bf16x8 pa0, pa1, pa2, pa3;
    PK4(p0, 0, pa0); PK4(p0, 8, pa1); PK4(p1, 0, pa2); PK4(p1, 8, pa3);
#pragma unroll
    for (int d0 = 0; d0 < 6; ++d0) { const u32x4 w = *reinterpret_cast<const u32x4*>(&qr[d0]); u32x4 o_;
#pragma unroll
        for (int j = 0; j < 4; ++j) o_[j] = cvtpk(bf_lo(w[j]) * inter, bf_hi(w[j]) * inter);
        qr[d0] = *reinterpret_cast<bf16x8*>(&o_); }
    const bf16* orow = PROJ0 + (size_t)(tok0 + tr) * ML_P0LD + ML_OOFF + h * ML_DV + 4 * hi;
    u32x2 owp[6][4];
#pragma unroll
    for (int db = 0; db < 6; ++db)
#pragma unroll
        for (int g4 = 0; g4 < 4; ++g4) owp[db][g4] = *(const u32x2*)(orow + db * 32 + 8 * g4);
    float den;
    { f32x16 acc = f32x16{};
#pragma unroll
      for (int d0 = 0; d0 < 6; ++d0) acc = __builtin_amdgcn_mfma_f32_32x32x16_bf16(cp6[d0], qr[d0], acc, 0, 0, 0);
      const LAS unsigned char* vr = vT + (6 * 32 + r32) * ML_TROW + hi * 16;
      acc = __builtin_amdgcn_mfma_f32_32x32x16_bf16(*(const LAS bf16x8*)(vr), pa0, acc, 0, 0, 0);
      acc = __builtin_amdgcn_mfma_f32_32x32x16_bf16(*(const LAS bf16x8*)(vr + 32), pa1, acc, 0, 0, 0);
      acc = __builtin_amdgcn_mfma_f32_32x32x16_bf16(*(const LAS bf16x8*)(vr + 64), pa2, acc, 0, 0, 0);
      acc = __builtin_amdgcn_mfma_f32_32x32x16_bf16(*(const LAS bf16x8*)(vr + 96), pa3, acc, 0, 0, 0);
      den = __shfl(acc[0], r32); }
    f32x16 o[6];
#pragma unroll
    for (int db = 0; db < 6; ++db) { f32x16 acc = f32x16{};
        if (db + 2 < 6) {
#pragma unroll
            for (int d0 = 0; d0 < 6; ++d0) cpb[(db + 2) % 3][d0] = *(const bf16x8*)(Cp + (size_t)(db + 2) * 32 * ML_DK + d0 * 16); }
#pragma unroll
        for (int d0 = 0; d0 < 6; ++d0) acc = __builtin_amdgcn_mfma_f32_32x32x16_bf16(cpb[db % 3][d0], qr[d0], acc, 0, 0, 0);
        const LAS unsigned char* vr = vT + (db * 32 + r32) * ML_TROW + hi * 16;
        acc = __builtin_amdgcn_mfma_f32_32x32x16_bf16(*(const LAS bf16x8*)(vr), pa0, acc, 0, 0, 0);
        acc = __builtin_amdgcn_mfma_f32_32x32x16_bf16(*(const LAS bf16x8*)(vr + 32), pa1, acc, 0, 0, 0);
        acc = __builtin_amdgcn_mfma_f32_32x32x16_bf16(*(const LAS bf16x8*)(vr + 64), pa2, acc, 0, 0, 0);
        acc = __builtin_amdgcn_mfma_f32_32x32x16_bf16(*(const LAS bf16x8*)(vr + 96), pa3, acc, 0, 0, 0);
        o[db] = acc; }
    const float hs = 1.0f / fmaxf(fabsf(den), expf(-mt));
    float ssq = 0.f;
#pragma unroll
    for (int db = 0; db < 6; ++db)
#pragma unroll
        for (int r = 0; r < 16; ++r) { o[db][r] *= hs; ssq += o[db][r] * o[db][r]; }
    ssq = swap_add(ssq);
    const float rs = 1.0f / sqrtf(ssq * (1.0f / ML_DV) + 1e-6f);
    bf16* mrow = MIX + (size_t)(tok0 + tr) * 1024 + h * ML_DV + 4 * hi; const float* hg = head_g + h * ML_DV + 4 * hi;
#pragma unroll
    for (int db = 0; db < 6; ++db)
#pragma unroll
        for (int g4 = 0; g4 < 4; ++g4) { const int d = db * 32 + 8 * g4; const u32x2 ow = owp[db][g4]; const f32x4 gg = *(const f32x4*)(hg + d);
            const float o0 = bf_lo(ow.x), o1 = bf_hi(ow.x), o2 = bf_lo(ow.y), o3 = bf_hi(ow.y);
#define ML_SIG(x_) __builtin_amdgcn_rcpf(1.0f + __builtin_amdgcn_exp2f(-1.4426950408889634f * (x_)))
            const float y0 = o[db][4 * g4] * rs * gg[0] * ML_SIG(o0), y1 = o[db][4 * g4 + 1] * rs * gg[1] * ML_SIG(o1);
            const float y2 = o[db][4 * g4 + 2] * rs * gg[2] * ML_SIG(o2), y3 = o[db][4 * g4 + 3] * rs * gg[3] * ML_SIG(o3);
#undef ML_SIG
            u32x2 w; w.x = cvtpk(y0, y1); w.y = cvtpk(y2, y3); *(u32x2*)(mrow + d) = w; }
    __syncthreads();
}
#ifndef FFN2_FP8
#define FFN2_FP8 0
#endif
#ifndef MOE1_PEEL
#define MOE1_PEEL 0
#endif
#ifndef KFIN_FUSED
#define KFIN_FUSED 0
#endif
#ifndef YP_FP8
#define YP_FP8 0
#endif
#ifndef MEM0_IN_SCAN
#define MEM0_IN_SCAN 0
#endif
#ifndef L1_FP8
#define L1_FP8 0
#endif
constexpr int NWAVES = 8;
constexpr int T = 16384, D = 1024, SEQ = 2048, NB = 8, FF = 3584, NEXP = 8;
constexpr int NMEMROWS = 2048;
constexpr int SLOT_ROWS = 34816;
constexpr float EPS = 1e-6f;

constexpr size_t MiB = 1u << 20;
constexpr size_t WS_CTL = 0, CTL_ZERO_BYTES = 65536;
constexpr size_t WS_W_IN0 = 1 * MiB, WS_W_MEM = 6 * MiB, WS_W_OUT0 = 8 * MiB, WS_W_GU0 = 10 * MiB, WS_W_D0 = 24 * MiB, WS_W_IN1 = 31 * MiB, WS_W_UKV = 33 * MiB, WS_W_UQ = 34 * MiB,
                 WS_W_OUT1 = 35 * MiB, WS_W_GU1 = 37 * MiB, WS_W_D1 = 149 * MiB;
constexpr size_t WS_XB = 205 * MiB, WS_MIX = 237 * MiB, WS_XA = 269 * MiB, WS_XC = 333 * MiB, WS_MEMB = 397 * MiB, WS_MEMKV = 401 * MiB, WS_SM = 405 * MiB;
constexpr size_t WS_R0 = WS_SM, WS_RM = WS_SM + 65536, WS_IFG = WS_SM + 131072, WS_SS = WS_SM + 1 * MiB, WS_SSKV = WS_SM + 2 * MiB, WS_SSQ = WS_SM + 2 * MiB + 524288, WS_GLML = WS_SM + 3 * MiB,
                 WS_MPREV = WS_SM + 3 * MiB + 65536, WS_ROPE = WS_SM + 4 * MiB, WS_TOPK = WS_SM + 8 * MiB, WS_RS3 = WS_SM + 8 * MiB + 524288, WS_SLOT_TOK = WS_SM + 9 * MiB,
                 WS_SLOT_GATE = WS_SM + 9 * MiB + 262144, WS_SLOT_RS = WS_SM + 9 * MiB + 524288, WS_TOK_SLOT = WS_SM + 9 * MiB + 786432;
constexpr size_t WS_X8 = 269 * MiB, WS_MIX8 = 301 * MiB;
constexpr size_t WS_PROJ0 = 421 * MiB, WS_CLOC = 501 * MiB, WS_CPREV = 543 * MiB, WS_H = 585 * MiB, WS_HP = 421 * MiB;
constexpr size_t WS_Z = 697 * MiB, WS_KVR = 729 * MiB, WS_QR = 777 * MiB, WS_KF = 817 * MiB, WS_AP = 697 * MiB, WS_YP = 765 * MiB, WS_END = 853 * MiB;
static_assert((size_t)SLOT_ROWS * FF * 2 <= 276 * MiB && (size_t)SLOT_ROWS * D * 2 <= 68 * MiB && (size_t)1024 * ML_CROWS * ML_DK * 2 <= 42 * MiB, "ws map");
constexpr int CW_TMO = 0, CW_BAR = 4096, CW_CNT = 8192, CW_CUR = 9216, CW_CVTQ = 10240;

constexpr int RING_BYTES = 131072, LDSCTL_OFF = RING_BYTES, MISC_OFF = LDSCTL_OFF + 320, LDS_BYTES = 147456;

typedef GAS unsigned gu32;
#define RLX_AGENT __ATOMIC_RELAXED, __HIP_MEMORY_SCOPE_AGENT
#define LDS_WAIT() asm volatile("s_waitcnt lgkmcnt(0)" ::: "memory")
#define VM_WAIT() asm volatile("s_waitcnt vmcnt(0)" ::: "memory")

#define XB_TMO      128
#define XB_XCNT(j)  (256  + 64 * (j))
#define XB_XSUB(j)  (1280 + 64 * (j))
#define XB_XGEN(j)  (2304 + 64 * (j))
#define XB_TOP      3328
#define XB_TOPGEN   3392
#define XCD_BAR_WORDS 3456
#define XB_SPIN_CAP (1u << 18)
__device__ __forceinline__ unsigned xb_ld(unsigned* p)              { return __hip_atomic_load(p, __ATOMIC_RELAXED, __HIP_MEMORY_SCOPE_AGENT); }
__device__ __forceinline__ unsigned xb_add(unsigned* p, unsigned v) { return __hip_atomic_fetch_add(p, v, __ATOMIC_RELAXED, __HIP_MEMORY_SCOPE_AGENT); }
__device__ __forceinline__ unsigned xb_xcc_id() { return (unsigned)__builtin_amdgcn_s_getreg((3 << 11) | 20) & 0xFu; }
#define XB_SPIN(cond, bar) do { unsigned _sp = 0; while (cond) { __builtin_amdgcn_s_sleep(1); \
    if ((++_sp & 255u) == 0u) { if (xb_ld(&(bar)[XB_TMO])) break; if (_sp > XB_SPIN_CAP) { atomicAdd(&(bar)[XB_TMO], 1u); break; } } } } while (0)
struct XcdBarrier { unsigned* bar; unsigned x; volatile LAS unsigned* st; int wave; };
__device__ __forceinline__ int lane_id() { return (int)__builtin_amdgcn_mbcnt_hi(~0u, __builtin_amdgcn_mbcnt_lo(~0u, 0u)); }
__device__ __forceinline__ XcdBarrier xcd_barrier_post(unsigned* bar, volatile LAS unsigned* st) {
    XcdBarrier b; b.bar = bar; b.x = xb_xcc_id(); b.st = st; b.wave = __builtin_amdgcn_readfirstlane((int)threadIdx.x >> 6);
    if (threadIdx.x == 0) (void)xb_add(&bar[XB_XCNT(b.x)], 1u);
    return b;
}
__device__ __forceinline__ void xcd_barrier_complete(unsigned* bar, unsigned x, unsigned& nloc, unsigned& nx) {
    const unsigned G = gridDim.x * gridDim.y * gridDim.z;
    unsigned sum, cnt, mine, sp = 0u;
    for (;;) {
        sum = 0u; cnt = 0u; mine = 0u;
#pragma unroll
        for (unsigned j = 0; j < 16; ++j) { const unsigned c = xb_ld(&bar[XB_XCNT(j)]); sum += c; cnt += (c > 0u) ? 1u : 0u; mine = (j == x) ? c : mine; }
        if (sum == G) break;
        __builtin_amdgcn_s_sleep(1);
        if ((++sp & 255u) == 0u) { if (xb_ld(&bar[XB_TMO])) break; if (sp > XB_SPIN_CAP) { atomicAdd(&bar[XB_TMO], 1u); break; } }
    }
    nloc = mine > 0u ? mine : 1u; nx = cnt > 0u ? cnt : 1u;
}
__device__ __forceinline__ void xcd_barrier(const XcdBarrier& b) {
    asm volatile("s_waitcnt vmcnt(0)" ::: "memory");
    __syncthreads();
    if (b.wave == 0 && lane_id() == 0) {
        unsigned* bar = b.bar;
        __builtin_amdgcn_s_waitcnt(0);
        unsigned nloc = b.st[0], nx = b.st[1];
        if (nloc == 0u) { xcd_barrier_complete(bar, b.x, nloc, nx); b.st[0] = nloc; b.st[1] = nx; }
        const unsigned old = xb_add(&bar[XB_XSUB(b.x)], 1u);
        const unsigned gen = old / nloc;
        if (old + 1u == (gen + 1u) * nloc) {
            __builtin_amdgcn_fence(__ATOMIC_RELEASE, "agent");
            asm volatile("s_waitcnt vmcnt(0)" ::: "memory");
            const unsigned og = xb_add(&bar[XB_TOP], 1u);
            const unsigned tg = og / nx;
            if (og + 1u == (tg + 1u) * nx) xb_add(&bar[XB_TOPGEN], 1u);
            else XB_SPIN(xb_ld(&bar[XB_TOPGEN]) == tg, bar);
            __builtin_amdgcn_fence(__ATOMIC_ACQUIRE, "agent");
            xb_add(&bar[XB_XGEN(b.x)], 1u);
            asm volatile("s_waitcnt vmcnt(0)" ::: "memory");
        } else {
            XB_SPIN(xb_ld(&bar[XB_XGEN(b.x)]) == gen, bar);
            __builtin_amdgcn_fence(__ATOMIC_ACQUIRE, "agent");
            asm volatile("s_waitcnt vmcnt(0)" ::: "memory");
        }
    }
    __syncthreads();
}

struct Args { const void* in[29]; float* out; unsigned char* ws; float inv[32]; int ph_lo, ph_hi, dbg, pad; };

struct Frame {
    LAS unsigned char* lds; volatile LAS unsigned* MISC; unsigned* ctl; unsigned char* ws;
    int tid, lane, wave, G, gw, NGW;
};

struct CvtJob { const float* W; const float* gain; bf16* WT; int ldw, K, dst_row0, src_col0, nblk, mode; };
__device__ __forceinline__ int cvt_src_col(const CvtJob& J, int nb) { if ((J.mode & 3) == 1) { const int pn = nb >> 3, j = nb & 7; return ((j < 4) ? 0 : FF) + 128 * pn + 32 * (j & 3); } return J.src_col0 + 32 * nb; }
#ifndef CVT_RUN
#define CVT_RUN 4
#endif
__device__ __forceinline__ void cvt_kbnb(const CvtJob& J, int item, int& kb, int& nb) {
    if (CVT_RUN <= 1) { kb = item / J.nblk; nb = item % J.nblk; return; }
    const int KB = J.K / 64, GK = (KB % 4 == 0) ? 4 : 2, per = J.nblk * GK, kq = item / per, rem = item % per;
    nb = rem / GK; kb = kq * GK + rem % GK;
}
__device__ __forceinline__ void cvt_load(const CvtJob& J, int item, int lane, f32x4 (&ld)[8]) {
    if ((J.mode & 3) == 2) return;
    int kb, nb; cvt_kbnb(J, item, kb, nb); const int k0 = 64 * kb, sc = cvt_src_col(J, nb);
    const float* src = J.W + (size_t)(k0 + (lane >> 3)) * J.ldw + sc + 4 * (lane & 7);
#pragma unroll
    for (int i = 0; i < 8; ++i) ld[i] = __builtin_nontemporal_load((const f32x4*)(src + (size_t)(8 * i) * J.ldw));
}
__device__ __forceinline__ void cvt_finish(const CvtJob& J, int item, LAS float* scr, int lane, const f32x4 (&ld)[8]) {
    int kb, nb; cvt_kbnb(J, item, kb, nb); const int k0 = 64 * kb;
    const int c = lane & 7;
    const bool f8 = (J.mode & 4) != 0;
    bf16* dstb = J.WT + (size_t)(J.dst_row0 + 32 * nb) * J.K + k0 + 8 * c;
    if ((J.mode & 3) == 2) {
        if (f8) { unsigned char* z8 = (unsigned char*)J.WT + (size_t)(J.dst_row0 + 32 * nb + (lane >> 1)) * J.K + k0 + 32 * (lane & 1);
            *(u32x4*)z8 = (u32x4){0u, 0u, 0u, 0u}; *(u32x4*)(z8 + 16) = (u32x4){0u, 0u, 0u, 0u}; return; }
#pragma unroll
        for (int j = 0; j < 4; ++j) { const int n = (lane >> 3) + 8 * j; *(u32x4*)(dstb + (size_t)n * J.K) = (u32x4){0u, 0u, 0u, 0u}; }
        return;
    }
#pragma unroll
    for (int i = 0; i < 8; ++i) { LAS float* d = scr + (8 * i + (lane >> 3)) * 33 + 4 * (lane & 7); d[0] = ld[i][0]; d[1] = ld[i][1]; d[2] = ld[i][2]; d[3] = ld[i][3]; }
    LDS_WAIT(); asm volatile("" ::: "memory");
    if (f8) {
        const int c4 = lane & 3; unsigned char* d8 = (unsigned char*)J.WT + (size_t)(J.dst_row0 + 32 * nb) * J.K + k0 + 16 * c4;
        float gk[16];
        const float wsc = ((J.mode & 3) == 1) ? (((nb & 7) < 4) ? 64.0f * 1.4426950408889634f : 64.0f * 4.0f / 1.4426950408889634f) : 64.0f;
#pragma unroll
        for (int i = 0; i < 16; ++i) gk[i] = (J.gain ? J.gain[k0 + 16 * c4 + i] : 1.f) * wsc;
#pragma unroll
        for (int j = 0; j < 2; ++j) { const int n = (lane >> 2) + 16 * j; const LAS float* s = scr + (16 * c4) * 33 + n; u32x4 o;
#pragma unroll
            for (int q = 0; q < 4; ++q) o[q] = pg8::pk4_fp8(s[(4 * q) * 33] * gk[4 * q], s[(4 * q + 1) * 33] * gk[4 * q + 1], s[(4 * q + 2) * 33] * gk[4 * q + 2], s[(4 * q + 3) * 33] * gk[4 * q + 3]);
            *(u32x4*)(d8 + (size_t)n * J.K) = o; }
        LDS_WAIT(); asm volatile("" ::: "memory");
        return; }
    f32x4 g0 = (f32x4){1.f, 1.f, 1.f, 1.f}, g1 = g0;
    if (J.gain) { g0 = *(const f32x4*)(J.gain + k0 + 8 * c); g1 = *(const f32x4*)(J.gain + k0 + 8 * c + 4); }
#pragma unroll
    for (int j = 0; j < 4; ++j) { const int n = (lane >> 3) + 8 * j; const LAS float* s = scr + (8 * c) * 33 + n;
        u32x4 o; o.x = cvtpk(s[0 * 33] * g0[0], s[1 * 33] * g0[1]); o.y = cvtpk(s[2 * 33] * g0[2], s[3 * 33] * g0[3]); o.z = cvtpk(s[4 * 33] * g1[0], s[5 * 33] * g1[1]); o.w = cvtpk(s[6 * 33] * g1[2], s[7 * 33] * g1[3]);
        *(u32x4*)(dstb + (size_t)n * J.K) = o; }
    LDS_WAIT(); asm volatile("" ::: "memory");
}
#define F32IN(i) ((const float*)A.in[i])
#define WSP(T_, off) ((T_*)(F.ws + (off)))
#define CVT_JOB(W_, g_, WT_, ldw_, K_, r0_, c0_, nblk_, mode_) if (!found) { const int n_ = ((K_) / 64) * (nblk_); if (r < n_) { J.W = (W_); J.gain = (g_); J.WT = (WT_); J.ldw = (ldw_); J.K = (K_); J.dst_row0 = (r0_); J.src_col0 = (c0_); J.nblk = (nblk_); J.mode = (mode_); found = true; } else r -= n_; }
constexpr int CVT_SMALL_ITEMS = 16 * 72 + 16 * 8 + 2 * 16 * 16 + 16 * 32 + 16 * 224 + 56 * 32 + 16 * 8 + 16 * 12 + 16 * 2 + 16 * 2 + 16 * 8 + 4 * 48 + 6 * 36 + 6 * 4 + 16 * 32;
constexpr int CVT_GU1_ITEMS = 16 * 224, CVT_D1_ITEMS = 56 * 32, CVT_TOTAL_ITEMS = CVT_SMALL_ITEMS + 8 * (CVT_GU1_ITEMS + CVT_D1_ITEMS);
__device__ __forceinline__ int cvt_lookup(const Args& A, Frame& F, int item, CvtJob& J) {
    J.W = nullptr; J.gain = nullptr; J.WT = nullptr; J.ldw = 0; J.K = 64; J.dst_row0 = 0; J.src_col0 = 0; J.nblk = 1; J.mode = 2;
    bool found = false; int r = item;
    if (r >= CVT_SMALL_ITEMS) { r -= CVT_SMALL_ITEMS;
        if (r < 8 * CVT_GU1_ITEMS) { const int e = r / CVT_GU1_ITEMS; r -= e * CVT_GU1_ITEMS;
            J.W = F32IN(27) + (size_t)e * D * 2 * FF; J.gain = F32IN(23) + D; J.WT = (bf16*)(F.ws + WS_W_GU1 + (size_t)e * 2 * FF * D); J.ldw = 2 * FF; J.K = D; J.nblk = 224; J.mode = 5; }
        else { r -= 8 * CVT_GU1_ITEMS; const int e = r / CVT_D1_ITEMS; r -= e * CVT_D1_ITEMS;
            J.W = F32IN(28) + (size_t)e * FF * D; J.gain = nullptr; J.WT = (bf16*)(F.ws + WS_W_D1 + (size_t)e * D * FF); J.ldw = D; J.K = FF; J.nblk = 32; J.mode = 4; }
        found = true; }
    CVT_JOB(F32IN(4), F32IN(3), WSP(bf16, WS_W_IN0), 2568, 1024, 0, 0, 72, 0)
    CVT_JOB(F32IN(4), F32IN(3), WSP(bf16, WS_W_IN0), 2568, 1024, 2304, 2312, 8, 0)
    CVT_JOB(F32IN(20), F32IN(19), WSP(bf16, WS_W_MEM), 512, 1024, 0, 0, 16, 0)
    CVT_JOB(F32IN(20) + (size_t)D * 512, F32IN(19) + D, WSP(bf16, WS_W_MEM), 512, 1024, 512, 0, 16, 0)
    CVT_JOB(F32IN(7), nullptr, WSP(bf16, WS_W_OUT0), 1024, 1024, 0, 0, 32, 0)
    CVT_JOB(F32IN(24), F32IN(23), WSP(bf16, WS_W_GU0), 2 * FF, 1024, 0, 0, 224, 1)
    CVT_JOB(F32IN(25), nullptr, WSP(bf16, WS_W_D0), 1024, FF, 0, 0, 32, FFN2_FP8 ? 4 : 0)
    CVT_JOB(F32IN(15), F32IN(14), WSP(bf16, WS_W_IN1), 320, 1024, 0, 0, 8, L1_FP8 ? 4 : 0)
    CVT_JOB(F32IN(9), F32IN(8), WSP(bf16, WS_W_IN1), 640, 1024, 256, 0, 12, L1_FP8 ? 4 : 0)
    CVT_JOB(F32IN(15), F32IN(14), WSP(bf16, WS_W_IN1), 320, 1024, 640, 256, 2, L1_FP8 ? 4 : 0)
    CVT_JOB(nullptr, nullptr, WSP(bf16, WS_W_IN1), 0, 1024, 704, 0, 2, L1_FP8 ? 6 : 2)
    CVT_JOB(F32IN(9), F32IN(8), WSP(bf16, WS_W_IN1), 640, 1024, 768, 384, 8, L1_FP8 ? 4 : 0)
    CVT_JOB(F32IN(17), F32IN(16), WSP(bf16, WS_W_UKV), 1536, 256, 0, 0, 48, 0)
    CVT_JOB(F32IN(11), F32IN(10), WSP(bf16, WS_W_UQ), 1152, 384, 0, 0, 36, 0)
    CVT_JOB(nullptr, nullptr, WSP(bf16, WS_W_UQ), 0, 384, 1152, 0, 4, 2)
    CVT_JOB(F32IN(13), nullptr, WSP(bf16, WS_W_OUT1), 1024, 1024, 0, 0, 32, L1_FP8 ? 4 : 0)
    if (!found) { J.mode = 2; J.WT = nullptr; r = -1; }
    return r;
}

constexpr int TBL_OFF = 98304;
__device__ __forceinline__ void fill_tbl8(Frame& F, const float* W, int ldw, int col0, const float* gain) {
    LAS float* tA = (LAS float*)(F.lds + TBL_OFF); LAS float* tB = tA + 4096;
    for (int i = F.tid; i < 1024 * 8; i += NWAVES * 64) { const int k = i >> 3, cc = i & 7, pos = (k & 3) * 256 + (k >> 2); const float v = W[(size_t)k * ldw + col0 + cc] * gain[k];
        if (cc < 4) tA[pos * 4 + cc] = v; else tB[pos * 4 + (cc - 4)] = v; }
    __syncthreads();
}
__device__ __forceinline__ void row_dot8(Frame& F, const f32x4 (&v)[4], float (&dot)[8]) {
    const LAS f32x4* tA = (const LAS f32x4*)(F.lds + TBL_OFF); const LAS f32x4* tB = tA + 1024;
#pragma unroll
    for (int cidx = 0; cidx < 8; ++cidx) dot[cidx] = 0.f;
#pragma unroll
    for (int j = 0; j < 4; ++j)
#pragma unroll
        for (int e = 0; e < 4; ++e) { const int pos = e * 256 + 64 * j + F.lane; const f32x4 a = tA[pos], b = tB[pos]; const float x = v[j][e];
            dot[0] += x * a[0]; dot[1] += x * a[1]; dot[2] += x * a[2]; dot[3] += x * a[3]; dot[4] += x * b[0]; dot[5] += x * b[1]; dot[6] += x * b[2]; dot[7] += x * b[3]; }
#pragma unroll
    for (int cidx = 0; cidx < 8; ++cidx) dot[cidx] = wave_sum(dot[cidx]);
}
__device__ __forceinline__ float row_load_ss(const float* xrow, int lane, f32x4 (&v)[4]) {
    const f32x4* xr = (const f32x4*)xrow + lane; float s = 0.f;
#pragma unroll
    for (int j = 0; j < 4; ++j) { v[j] = __builtin_nontemporal_load(xr + 64 * j); s += (v[j][0] * v[j][0] + v[j][1] * v[j][1]) + (v[j][2] * v[j][2] + v[j][3] * v[j][3]); }
    return wave_sum(s);
}
__device__ __forceinline__ void row_load(const float* xrow, int lane, f32x4 (&v)[4]) {
    const f32x4* xr = (const f32x4*)xrow + lane;
#pragma unroll
    for (int j = 0; j < 4; ++j) v[j] = __builtin_nontemporal_load(xr + 64 * j);
}
__device__ __forceinline__ float row_ss(const f32x4 (&v)[4]) { float s = 0.f;
#pragma unroll
    for (int j = 0; j < 4; ++j) s += (v[j][0] * v[j][0] + v[j][1] * v[j][1]) + (v[j][2] * v[j][2] + v[j][3] * v[j][3]);
    return wave_sum(s);
}
__device__ __forceinline__ void row_load_bf16(const bf16* xrow, int lane, u32x2 (&w)[4]) {
    const u32x2* xr = (const u32x2*)xrow + lane;
#pragma unroll
    for (int j = 0; j < 4; ++j) w[j] = xr[64 * j];
}
__device__ __forceinline__ float row_unpack_ss_bf16(const u32x2 (&w)[4], f32x4 (&v)[4]) { float s = 0.f;
#pragma unroll
    for (int j = 0; j < 4; ++j) { v[j] = (f32x4){bf_lo(w[j].x), bf_hi(w[j].x), bf_lo(w[j].y), bf_hi(w[j].y)}; s += (v[j][0] * v[j][0] + v[j][1] * v[j][1]) + (v[j][2] * v[j][2] + v[j][3] * v[j][3]); }
    return wave_sum(s);
}
__device__ __forceinline__ float row_load_ss_bf16(const bf16* xrow, int lane, f32x4 (&v)[4]) {
    const u32x2* xr = (const u32x2*)xrow + lane; float s = 0.f;
#pragma unroll
    for (int j = 0; j < 4; ++j) { const u32x2 w = xr[64 * j]; v[j] = (f32x4){bf_lo(w.x), bf_hi(w.x), bf_lo(w.y), bf_hi(w.y)}; s += (v[j][0] * v[j][0] + v[j][1] * v[j][1]) + (v[j][2] * v[j][2] + v[j][3] * v[j][3]); }
    return wave_sum(s);
}
__device__ __forceinline__ void row_store_bf16(bf16* orow, int lane, const f32x4 (&v)[4]) {
    u32x2* o8 = (u32x2*)orow + lane;
#pragma unroll
    for (int j = 0; j < 4; ++j) { u32x2 w; w.x = cvtpk(v[j][0], v[j][1]); w.y = cvtpk(v[j][2], v[j][3]); o8[64 * j] = w; }
}

constexpr int CVT_LATE_ITEMS = CVT_TOTAL_ITEMS - CVT_SMALL_ITEMS, CVT_CHUNK = 8;
__device__ __forceinline__ void cvt_queue(const Args& A, Frame& F, int quota) {
    LAS float* scr = (LAS float*)(F.lds + F.wave * 8704);
    for (;;) {
        int h = 0; if (F.lane == 0) h = (int)__hip_atomic_fetch_add(F.ctl + CW_CVTQ, (unsigned)CVT_CHUNK, RLX_AGENT);
        h = __builtin_amdgcn_readfirstlane(h);
        if (h >= CVT_LATE_ITEMS) break;
        const int e = (h + CVT_CHUNK < CVT_LATE_ITEMS) ? h + CVT_CHUNK : CVT_LATE_ITEMS;
        CvtJob Jc; int rc = cvt_lookup(A, F, CVT_SMALL_ITEMS + h, Jc); f32x4 ldc[8]; cvt_load(Jc, rc, F.lane, ldc);
        for (int it = h; it < e; ++it) { CvtJob Jn; int rn = -1; f32x4 ldn[8];
#pragma unroll
            for (int i = 0; i < 8; ++i) ldn[i] = ldc[i];
            if (it + 1 < e) { rn = cvt_lookup(A, F, CVT_SMALL_ITEMS + it + 1, Jn); cvt_load(Jn, rn, F.lane, ldn); }
            cvt_finish(Jc, rc, scr, F.lane, ldc);
            Jc = Jn; rc = rn;
#pragma unroll
            for (int i = 0; i < 8; ++i) ldc[i] = ldn[i]; }
        if (h >= quota) break;
    }
}
#define CVT_QUOTA(pct) ((int)((long)CVT_LATE_ITEMS * (pct) / 100))
enum { PH_PRO = 0, PH_PROJ0, PH_MLA_MEM0, PH_MLB, PH_MLC, PH_OUT0, PH_FFN1, PH_FFN2, PH_IN1, PH_UP1, PH_KFIN_MEM1, PH_ATTN, PH_OUT1, PH_ROUTE, PH_GATHER, PH_MOE1, PH_MOE2, PH_COMBINE, PH_DBG, N_PHASES };
#ifndef MK_ONE_LAUNCH
#define MK_ONE_LAUNCH 0
#endif
#ifndef DBG_MODE
#define DBG_MODE 0
#endif
#ifndef REPEAT_MASK
#define REPEAT_MASK 0u
#endif
#define REPS(k) (1 + (int)((REPEAT_MASK >> (k)) & 1u))
#ifndef DBG_LAST
#define DBG_LAST N_PHASES
#endif

__global__ void __launch_bounds__(NWAVES * 64, 2) fwd_kernel(Args A) {
    extern __shared__ __attribute__((aligned(16))) unsigned char lds_raw[];
    Frame F;
    F.lds = (LAS unsigned char*)lds_raw; F.MISC = (volatile LAS unsigned*)(F.lds + MISC_OFF);
    F.tid = threadIdx.x; F.lane = F.tid & 63; F.wave = __builtin_amdgcn_readfirstlane(F.tid >> 6);
    F.G = gridDim.x; F.ws = A.ws; F.ctl = (unsigned*)(A.ws + WS_CTL);
    { const int bx = blockIdx.x; const int vcu = (F.G % 8 == 0) ? (bx % 8) * (F.G / 8) + bx / 8 : bx; F.gw = vcu * NWAVES + F.wave; F.NGW = F.G * NWAVES; }
    for (int u = F.tid; u < (LDS_BYTES - LDSCTL_OFF) / 4; u += NWAVES * 64) ((LAS unsigned*)(F.lds + LDSCTL_OFF))[u] = 0u;
    __syncthreads();
    const int lo = A.ph_lo, hi = A.ph_hi;
    XcdBarrier bar; bar.bar = F.ctl + CW_BAR; bar.x = 0; bar.st = nullptr; bar.wave = F.wave;
    if (hi - lo > 1) bar = xcd_barrier_post(F.ctl + CW_BAR, F.MISC + 8);
#define IN(k) (lo <= (k) && (k) < hi)
#define PH_BEGIN() do { int t_ = F.wave * 64 + lane_id(); asm volatile("" : "+v"(t_)); F.tid = t_; F.lane = t_ & 63; } while (0)
#ifdef PROBE_DOUBLE_BAR
#define SEAM(k) do { if (IN(k) && IN((k) + 1)) { xcd_barrier(bar); xcd_barrier(bar); } } while (0)
#else
#define SEAM(k) do { if (IN(k) && IN((k) + 1)) xcd_barrier(bar); } while (0)
#endif
    const int bx = blockIdx.x;
    LAS unsigned char* ring = F.lds;

    if (IN(PH_PRO)) for (int rep_ = 0; rep_ < REPS(PH_PRO); ++rep_) { PH_BEGIN();
        LAS float* scr = (LAS float*)(ring + F.wave * 8704);
        { CvtJob Jc; int rc = -1; f32x4 ldc[8];
#define CVT_ITEM(i_) ((((i_) / CVT_RUN) * F.NGW + F.gw) * CVT_RUN + (i_) % CVT_RUN)
          if (CVT_ITEM(0) < CVT_TOTAL_ITEMS) { rc = cvt_lookup(A, F, CVT_ITEM(0), Jc); if (rc >= 0) cvt_load(Jc, rc, F.lane, ldc); }
          for (int ii = 0, it = CVT_ITEM(0); it < CVT_TOTAL_ITEMS; ++ii, it = CVT_ITEM(ii)) { CvtJob Jn; int rn = -1; f32x4 ldn[8]; const int itn = CVT_ITEM(ii + 1);
#pragma unroll
              for (int i = 0; i < 8; ++i) ldn[i] = ldc[i];
              if (itn < CVT_TOTAL_ITEMS) { rn = cvt_lookup(A, F, itn, Jn); if (rn >= 0) cvt_load(Jn, rn, F.lane, ldn); }
              if (rc >= 0) cvt_finish(Jc, rc, scr, F.lane, ldc);
              Jc = Jn; rc = rn;
#pragma unroll
              for (int i = 0; i < 8; ++i) ldc[i] = ldn[i]; } }
        __syncthreads();
        fill_tbl8(F, F32IN(4), 2568, 2304, F32IN(3));
        const float* x = F32IN(0); const float* gb = F32IN(5);
        f32x4 vn[4]; if (F.gw < T) row_load(x + (size_t)F.gw * D, F.lane, vn);
        for (int m = F.gw; m < T; m += F.NGW) { f32x4 v[4];
#pragma unroll
            for (int j = 0; j < 4; ++j) v[j] = vn[j];
            if (m + F.NGW < T) row_load(x + (size_t)(m + F.NGW) * D, F.lane, vn);
            const float ss = row_ss(v); const float r = 1.0f / sqrtf(ss * (1.0f / D) + EPS);
            row_store_bf16(WSP(bf16, WS_XB) + (size_t)m * D, F.lane, v);
            float dot[8]; row_dot8(F, v, dot);
            if (F.lane < 8) { float dv = dot[0];
#pragma unroll
                for (int cc = 1; cc < 8; ++cc) dv = (F.lane == cc) ? dot[cc] : dv;
                WSP(float, WS_IFG)[(size_t)m * 8 + F.lane] = dv * r + gb[F.lane]; }
            if (F.lane == 0) WSP(float, WS_R0)[m] = r; }
        const float* mem = F32IN(1);
        for (int m = F.gw; m < NMEMROWS; m += F.NGW) { f32x4 v[4]; const float ss = row_load_ss(mem + (size_t)m * D, F.lane, v);
            row_store_bf16(WSP(bf16, WS_MEMB) + (size_t)m * D, F.lane, v);
            if (F.lane == 0) WSP(float, WS_RM)[m] = 1.0f / sqrtf(ss * (1.0f / D) + EPS); }
        const int* pos = (const int*)A.in[2];
        for (int i = bx * 512 + F.tid; i < T * 32; i += F.G * 512) { const float ang = (float)pos[i >> 5] * A.inv[i & 31]; float sn, cs; sincosf(ang, &sn, &cs); WSP(f32x2, WS_ROPE)[i] = (f32x2){cs, sn}; }
        __syncthreads();
    }
    SEAM(PH_PRO);
    if (IN(PH_PROJ0)) for (int rep_ = 0; rep_ < REPS(PH_PROJ0); ++rep_) { PH_BEGIN();
        { pg8::Gemm g{WSP(bf16, WS_XB), WSP(bf16, WS_W_IN0), D, D}; pg8::StaticOrder S; S.init(T / 256, 10, F.G, bx);
          pg8::EpiScaleBf16<0> E{WSP(bf16, WS_PROJ0), 2560, pg8::RowScaleT<0>{WSP(float, WS_R0), 0.f}, 1 << 20};
          pg8::gemm_phase(F.tid, ring, g, S, E); }
        { pg8::Gemm g{WSP(bf16, WS_MEMB), WSP(bf16, WS_W_MEM), D, D}; pg8::StaticOrder S; S.init(NMEMROWS / 256, 4, F.G, (bx + F.G / 2) % F.G);
          pg8::EpiScaleBf16<0> E{WSP(bf16, WS_MEMKV), 1024, pg8::RowScaleT<0>{WSP(float, WS_RM), 0.f}, 1 << 20};
          pg8::gemm_phase(F.tid, ring, g, S, E); }
    }
    SEAM(PH_PROJ0);
    if (IN(PH_MLA_MEM0)) for (int rep_ = 0; rep_ < REPS(PH_MLA_MEM0); ++rep_) { PH_BEGIN();
        mlstm_a_wg(F.tid, ring, bx, F.G, 1024, WSP(bf16, WS_PROJ0), WSP(float, WS_IFG), WSP(bf16, WS_CLOC), WSP(float, WS_GLML));
#if !MEM0_IN_SCAN
        for (int u = bx; u < 256; u += F.G) { const int b = u >> 5, h = (u >> 3) & 3, qb = u & 7; const size_t row0 = (size_t)b * SEQ + qb * 256;
            attn_unit<64, 64, false, true, false>(F.tid, ring, WSP(bf16, WS_PROJ0) + row0 * 2560 + 2304 + h * 64, 2560, WSP(bf16, WS_MEMKV) + (size_t)b * 256 * 1024 + h * 64, 1024,
                WSP(bf16, WS_MEMKV) + (size_t)b * 256 * 1024 + 256 + h * 64, 1024, WSP(bf16, WS_MIX) + row0 * 1024 + 768 + h * 64, 1024, 4, 0, F32IN(21), F32IN(22), 0.125f * 1.4426950408889634f, nullptr); }
#endif
    }
    SEAM(PH_MLA_MEM0);
    if (IN(PH_MLB)) for (int rep_ = 0; rep_ < REPS(PH_MLB); ++rep_) { PH_BEGIN(); for (int wi = bx; wi < (ML_SCAN8 ? 256 : 160); wi += F.G) mlstm_b_item(F.tid, wi, WSP(bf16, WS_CLOC), WSP(bf16, WS_CPREV), WSP(float, WS_GLML), WSP(float, WS_MPREV));
#if MEM0_IN_SCAN
        for (int u = (F.G > 160 ? bx - 160 : bx); u >= 0 && u < 256; u += (F.G > 160 ? F.G - 160 : F.G)) { const int b = u >> 5, h = (u >> 3) & 3, qb = u & 7; const size_t row0 = (size_t)b * SEQ + qb * 256;
            attn_unit<64, 64, false, true, false>(F.tid, ring, WSP(bf16, WS_PROJ0) + row0 * 2560 + 2304 + h * 64, 2560, WSP(bf16, WS_MEMKV) + (size_t)b * 256 * 1024 + h * 64, 1024,
                WSP(bf16, WS_MEMKV) + (size_t)b * 256 * 1024 + 256 + h * 64, 1024, WSP(bf16, WS_MIX) + row0 * 1024 + 768 + h * 64, 1024, 4, 0, F32IN(21), F32IN(22), 0.125f * 1.4426950408889634f, nullptr); }
#endif
    }
    SEAM(PH_MLB);
    if (IN(PH_MLC)) for (int rep_ = 0; rep_ < REPS(PH_MLC); ++rep_) { PH_BEGIN(); for (int gi = bx; gi < 256; gi += F.G) mlstm_c_group(F.tid, ring, gi * 4, WSP(bf16, WS_PROJ0), WSP(float, WS_IFG), WSP(bf16, WS_CPREV), WSP(float, WS_MPREV), F32IN(6), WSP(bf16, WS_MIX)); }
    SEAM(PH_MLC);
    if (IN(PH_OUT0)) for (int rep_ = 0; rep_ < REPS(PH_OUT0); ++rep_) { PH_BEGIN();
        pg8::Gemm g{WSP(bf16, WS_MIX), WSP(bf16, WS_W_OUT0), D, D}; pg8::StaticOrder S; S.init(T / 256, 4, F.G, bx);
        pg8::EpiResidualBf16 E{WSP(bf16, WS_XB), WSP(float, WS_SS), D, nullptr};
        pg8::gemm_phase(F.tid, ring, g, S, E);
    }
    SEAM(PH_OUT0);
    if (IN(PH_FFN1)) for (int rep_ = 0; rep_ < REPS(PH_FFN1); ++rep_) { PH_BEGIN();
        pg8::Gemm g{WSP(bf16, WS_XB), WSP(bf16, WS_W_GU0), D, D}; pg8::StaticOrder S; S.init(T / 256, 28, F.G, bx);
#if FFN2_FP8
        pg8::EpiSwiGLU<true, 16> E{WSP(bf16, WS_H), FF, pg8::RowScaleT<16>{WSP(float, WS_SS), 1.0f / D}, 1 << 20, 4.f};
#else
        pg8::EpiSwiGLU<false, 16> E{WSP(bf16, WS_H), FF, pg8::RowScaleT<16>{WSP(float, WS_SS), 1.0f / D}, 1 << 20, 1.f};
#endif
        pg8::gemm_phase(F.tid, ring, g, S, E);
    }
    SEAM(PH_FFN1);
    if (IN(PH_FFN2)) for (int rep_ = 0; rep_ < REPS(PH_FFN2); ++rep_) { PH_BEGIN();
#if FFN2_FP8
        pg8::Gemm g{WSP(bf16, WS_H), WSP(bf16, WS_W_D0), FF / 2, FF / 2}; pg8::StaticOrder S; S.init(T / 256, 4, F.G, bx);
        pg8::EpiResidualBf16T<0x77777777u, 2, L1_FP8 != 0> E{WSP(bf16, WS_XB), WSP(float, WS_SS), D, F.ws + WS_X8};
        pg8::gemm_phase<decltype(E), decltype(S), true, true, false>(F.tid, ring, g, S, E);
#else
        pg8::Gemm g{WSP(bf16, WS_H), WSP(bf16, WS_W_D0), FF, FF}; pg8::StaticOrder S; S.init(T / 256, 4, F.G, bx);
        pg8::EpiResidualBf16T<0x7F7F7F7Fu, 4, L1_FP8 != 0> E{WSP(bf16, WS_XB), WSP(float, WS_SS), D, F.ws + WS_X8};
        pg8::gemm_phase(F.tid, ring, g, S, E);
#endif
    }
    SEAM(PH_FFN2);
    if (IN(PH_IN1)) for (int rep_ = 0; rep_ < REPS(PH_IN1); ++rep_) { PH_BEGIN();
#if L1_FP8
        pg8::Gemm g{WSP(bf16, WS_X8), WSP(bf16, WS_W_IN1), D / 2, D / 2}; pg8::StaticOrder S; S.init(T / 256, 4, F.G, bx);
        pg8::EpiInProj1T<0x79797979u> E{WSP(bf16, WS_Z), 1024, pg8::RowScaleT<16>{WSP(float, WS_SS), 1.0f / D}, WSP(float, WS_SSKV), WSP(float, WS_SSQ)};
        pg8::gemm_phase<decltype(E), decltype(S), true, true, false>(F.tid, ring, g, S, E);
#else
        pg8::Gemm g{WSP(bf16, WS_XB), WSP(bf16, WS_W_IN1), D, D}; pg8::StaticOrder S; S.init(T / 256, 4, F.G, bx);
        pg8::EpiInProj1 E{WSP(bf16, WS_Z), 1024, pg8::RowScaleT<16>{WSP(float, WS_SS), 1.0f / D}, WSP(float, WS_SSKV), WSP(float, WS_SSQ)};
        pg8::gemm_phase(F.tid, ring, g, S, E);
#endif
    }
    SEAM(PH_IN1);
    if (IN(PH_UP1)) for (int rep_ = 0; rep_ < REPS(PH_UP1); ++rep_) { PH_BEGIN();
        { pg8::Gemm g{WSP(bf16, WS_Z), WSP(bf16, WS_W_UKV), 1024, 256}; pg8::StaticOrder S; S.init(T / 256, 6, F.G, bx);
#if KFIN_FUSED
          pg8::EpiKvUp E{WSP(bf16, WS_KVR), 1536, pg8::RowScaleT<4>{WSP(float, WS_SSKV), 1.0f / 256}, WSP(bf16, WS_Z), WSP(float, WS_ROPE), F32IN(18), WSP(bf16, WS_KF), 11};
#else
          pg8::EpiScaleBf16<4> E{WSP(bf16, WS_KVR), 1536, pg8::RowScaleT<4>{WSP(float, WS_SSKV), 1.0f / 256}, 1 << 20};
#endif
          pg8::gemm_phase<decltype(E), decltype(S), false, true, true, false>(F.tid, ring, g, S, E); }
        { pg8::Gemm g{WSP(bf16, WS_Z) + 256, WSP(bf16, WS_W_UQ), 1024, 384}; pg8::StaticOrder S; S.init(T / 256, 5, F.G, (bx + F.G / 2) % F.G);
          pg8::EpiScaleBf16<8> E{WSP(bf16, WS_QR), 1280, pg8::RowScaleT<8>{WSP(float, WS_SSQ), 1.0f / 384}, 1 << 20};
          pg8::gemm_phase<decltype(E), decltype(S), false, true, true, false>(F.tid, ring, g, S, E); }
    }
    SEAM(PH_UP1);
#if !KFIN_FUSED
    if (IN(PH_KFIN_MEM1)) for (int rep_ = 0; rep_ < REPS(PH_KFIN_MEM1); ++rep_) { PH_BEGIN();
        const float* kg = F32IN(18);
        const float gr = kg[128 + F.lane]; const f32x2 gn = *(const f32x2*)(kg + 2 * F.lane);
        unsigned krn = 0u, wn[6]; f32x2 csn = (f32x2){0.f, 0.f};
#define KFIN_LOAD(m_) do { krn = (unsigned)WSP(bf16, WS_Z)[(size_t)(m_) * 1024 + 640 + F.lane]; csn = WSP(f32x2, WS_ROPE)[(size_t)(m_) * 32 + (F.lane & 31)]; \
            _Pragma("unroll") for (int h_ = 0; h_ < 6; ++h_) wn[h_] = __builtin_nontemporal_load((const unsigned*)(WSP(bf16, WS_KVR) + (size_t)(m_) * 1536 + h_ * 256 + 2 * F.lane)); } while (0)
        if (F.gw < T) KFIN_LOAD(F.gw);
        for (int m = F.gw; m < T; m += F.NGW) { const int b = m >> 11, s = m & 2047;
            const float kr = __uint_as_float(krn << 16); const f32x2 cs = csn; unsigned wc_[6];
#pragma unroll
            for (int h = 0; h < 6; ++h) wc_[h] = wn[h];
            if (m + F.NGW < T) KFIN_LOAD(m + F.NGW);
#pragma unroll
            for (int h = 0; h < 6; ++h) { const unsigned w = wc_[h]; const float a = bf_lo(w), c2 = bf_hi(w);
                const float ss = wave_sum(a * a + c2 * c2 + kr * kr); const float rk = 1.0f / sqrtf(ss * (1.0f / 192) + EPS);
                bf16* ko = WSP(bf16, WS_KF) + ((size_t)(b * 6 + h) * SEQ + s) * 192;
                *(unsigned*)(ko + 2 * F.lane) = cvtpk(a * rk * gn.x, c2 * rk * gn.y);
                const float y = kr * rk * gr, yp = __shfl_xor(y, 32); const float o_ = (F.lane < 32) ? (y * cs.x - yp * cs.y) : (y * cs.x + yp * cs.y);
                ko[128 + F.lane] = (bf16)(cvtpk(o_, 0.f) & 0xffffu); } }
#undef KFIN_LOAD
    }
    SEAM(PH_KFIN_MEM1);
#endif
    if (IN(PH_ATTN)) for (int rep_ = 0; rep_ < REPS(PH_ATTN); ++rep_) { PH_BEGIN();
        for (int bin = bx; bin < 240; bin += F.G) { const int grp = bin / 48, bh = bin % 48; const int qa = 7 - grp, qbb = (grp >= 1 && grp <= 3) ? grp - 1 : -1;
            for (int pass = 0; pass < 2; ++pass) { const int qb = pass ? qbb : qa; if (qb < 0) break;
                const int b = bh / 6, h = bh % 6; const size_t row0 = (size_t)b * SEQ + qb * 256;
                attn_unit<192, 128, true, false, true, L1_FP8 != 0>(F.tid, ring, WSP(bf16, WS_QR) + row0 * 1280 + h * 192, 1280, WSP(bf16, WS_KF) + (size_t)(b * 6 + h) * SEQ * 192, 192,
                    WSP(bf16, WS_KVR) + (size_t)b * SEQ * 1536 + h * 256 + 128, 1536, L1_FP8 ? (bf16*)(F.ws + WS_MIX8 + row0 * 1024 + h * 128) : WSP(bf16, WS_MIX) + row0 * 1024 + h * 128, 1024, 4 * (qb + 1), qb * 256, F32IN(12), nullptr,
                    0.07216878364870322f * 1.4426950408889634f, WSP(f32x2, WS_ROPE) + row0 * 32); } }
        for (int u = (F.G >= 256 ? (bx >= 240 ? (bx - 240) * 8 : (bx >= 192 ? 128 + (bx - 192) * 3 : 256)) : bx), ue = (F.G >= 256 ? (bx >= 240 ? u + 8 : (u + 3 < 256 ? u + 3 : 256)) : 256); u < ue; u += (F.G >= 256 ? 1 : F.G)) { const int b = u >> 5, h = (u >> 3) & 3, qb = u & 7; const size_t row0 = (size_t)b * SEQ + qb * 256;
            attn_unit<64, 64, false, true, false, L1_FP8 != 0>(F.tid, ring, WSP(bf16, WS_Z) + row0 * 1024 + 768 + h * 64, 1024, WSP(bf16, WS_MEMKV) + (size_t)b * 256 * 1024 + 512 + h * 64, 1024,
                WSP(bf16, WS_MEMKV) + (size_t)b * 256 * 1024 + 768 + h * 64, 1024, L1_FP8 ? (bf16*)(F.ws + WS_MIX8 + row0 * 1024 + 768 + h * 64) : WSP(bf16, WS_MIX) + row0 * 1024 + 768 + h * 64, 1024, 4, 0, F32IN(21) + 64, F32IN(22) + 64, 0.125f * 1.4426950408889634f, nullptr); }
    }
    SEAM(PH_ATTN);
    if (IN(PH_OUT1)) for (int rep_ = 0; rep_ < REPS(PH_OUT1); ++rep_) { PH_BEGIN();
#if L1_FP8
        pg8::Gemm g{WSP(bf16, WS_MIX8), WSP(bf16, WS_W_OUT1), D / 2, D / 2}; pg8::StaticOrder S; S.init(T / 256, 4, F.G, bx);
        pg8::EpiResidualBf16T<0x79797979u, 2> E{WSP(bf16, WS_XB), WSP(float, WS_SS), D, nullptr};
        pg8::gemm_phase<decltype(E), decltype(S), true, true, false>(F.tid, ring, g, S, E);
#else
        pg8::Gemm g{WSP(bf16, WS_MIX), WSP(bf16, WS_W_OUT1), D, D}; pg8::StaticOrder S; S.init(T / 256, 4, F.G, bx);
        pg8::EpiResidualBf16 E{WSP(bf16, WS_XB), WSP(float, WS_SS), D, nullptr};
        pg8::gemm_phase(F.tid, ring, g, S, E);
#endif
    }
    SEAM(PH_OUT1);
    if (IN(PH_ROUTE)) { PH_BEGIN();
        fill_tbl8(F, F32IN(26), 8, 0, F32IN(23) + D);
        LAS unsigned* lcnt = (LAS unsigned*)(F.lds + 65536);
        if (F.tid < 8) lcnt[F.tid] = 0u;
        __syncthreads();
        u32x2 xwn[4]; if (F.gw < T) row_load_bf16(WSP(bf16, WS_XB) + (size_t)F.gw * D, F.lane, xwn);
        for (int m = F.gw; m < T; m += F.NGW) { f32x4 v[4]; u32x2 xwc[4];
#pragma unroll
            for (int j = 0; j < 4; ++j) xwc[j] = xwn[j];
            if (m + F.NGW < T) row_load_bf16(WSP(bf16, WS_XB) + (size_t)(m + F.NGW) * D, F.lane, xwn);
            const float ss = row_unpack_ss_bf16(xwc, v); const float r = 1.0f / sqrtf(ss * (1.0f / D) + EPS);
            float dot[8]; row_dot8(F, v, dot);
            int e1 = 0; float v1 = dot[0];
#pragma unroll
            for (int cc = 1; cc < 8; ++cc) if (dot[cc] > v1) { v1 = dot[cc]; e1 = cc; }
            int e2 = -1; float v2 = -__builtin_inff();
#pragma unroll
            for (int cc = 0; cc < 8; ++cc) if (cc != e1 && dot[cc] > v2) { v2 = dot[cc]; e2 = cc; }
            const float g1 = 1.0f / (1.0f + expf((v2 - v1) * r)), g2 = 1.0f - g1;
            if (F.lane == 0) { *(u32x4*)(WSP(unsigned, WS_TOPK) + (size_t)m * 4) = (u32x4){(unsigned)e1, (unsigned)e2, __float_as_uint(g1), __float_as_uint(g2)}; WSP(float, WS_RS3)[m] = r;
                atomicAdd((unsigned*)&lcnt[e1], 1u); atomicAdd((unsigned*)&lcnt[e2], 1u); } }
        __syncthreads();
        if (F.tid < 8 && lcnt[F.tid]) __hip_atomic_fetch_add(F.ctl + CW_CNT + 64 * F.tid, lcnt[F.tid], RLX_AGENT);
        __syncthreads();
    }
    SEAM(PH_ROUTE);
    if (IN(PH_GATHER)) { PH_BEGIN();
        LAS unsigned* lc = (LAS unsigned*)(F.lds + 65536);
        if (F.tid < 8) { lc[F.tid] = 0u; unsigned tb = 0u; for (int e = 0; e < F.tid; ++e) tb += (__hip_atomic_load(F.ctl + CW_CNT + 64 * e, RLX_AGENT) + 255u) >> 8; lc[16 + F.tid] = tb * 256u; }
        __syncthreads();
        for (int t0 = bx * 64; t0 < T; t0 += F.G * 64) {
            unsigned e1 = 0, e2 = 0, r1 = 0, r2 = 0; float g1 = 0.f, g2 = 0.f;
            if (F.tid < 64) { const u32x4 tk = *(const u32x4*)(WSP(unsigned, WS_TOPK) + (size_t)(t0 + F.tid) * 4); e1 = tk.x; e2 = tk.y; g1 = __uint_as_float(tk.z); g2 = __uint_as_float(tk.w);
                r1 = atomicAdd((unsigned*)&lc[e1], 1u); r2 = atomicAdd((unsigned*)&lc[e2], 1u); }
            __syncthreads();
            if (F.tid < 8) lc[8 + F.tid] = lc[F.tid] ? __hip_atomic_fetch_add(F.ctl + CW_CUR + 64 * F.tid, lc[F.tid], RLX_AGENT) : 0u;
            __syncthreads();
            if (F.tid < 64) { const int tok = t0 + F.tid; const unsigned s1 = lc[16 + e1] + lc[8 + e1] + r1, s2 = lc[16 + e2] + lc[8 + e2] + r2; const float r = WSP(float, WS_RS3)[tok];
                WSP(int, WS_SLOT_TOK)[s1] = tok; WSP(int, WS_SLOT_TOK)[s2] = tok; WSP(float, WS_SLOT_GATE)[s1] = g1 * ((YP_FP8 ? 16.0f : 1.0f) / 256.0f); WSP(float, WS_SLOT_GATE)[s2] = g2 * ((YP_FP8 ? 16.0f : 1.0f) / 256.0f); WSP(float, WS_SLOT_RS)[s1] = r * (1.0f / 64.0f); WSP(float, WS_SLOT_RS)[s2] = r * (1.0f / 64.0f);
                WSP(unsigned, WS_TOK_SLOT)[(size_t)tok * 2] = s1; WSP(unsigned, WS_TOK_SLOT)[(size_t)tok * 2 + 1] = s2; lc[32 + 2 * F.tid] = s1; lc[32 + 2 * F.tid + 1] = s2; }
            __syncthreads();
            for (int i0 = F.wave; i0 < 128; i0 += 4 * NWAVES) { u32x4 ga[4], gb[4]; unsigned gsl[4]; float grs[4];
#pragma unroll
                for (int q = 0; q < 4; ++q) { const int i = i0 + q * NWAVES; gsl[q] = lc[32 + i]; const int tok = t0 + (i >> 1); grs[q] = WSP(float, WS_RS3)[tok];
                    const u32x4* src = (const u32x4*)(WSP(bf16, WS_XB) + (size_t)tok * D) + 2 * F.lane; ga[q] = src[0]; gb[q] = src[1]; }
#pragma unroll
                for (int q = 0; q < 4; ++q) { const u32x4 a = ga[q], b = gb[q]; const float rr = grs[q];
                    u32x4 o; o.x = pg8::pk4_fp8(bf_lo(a.x) * rr, bf_hi(a.x) * rr, bf_lo(a.y) * rr, bf_hi(a.y) * rr); o.y = pg8::pk4_fp8(bf_lo(a.z) * rr, bf_hi(a.z) * rr, bf_lo(a.w) * rr, bf_hi(a.w) * rr);
                    o.z = pg8::pk4_fp8(bf_lo(b.x) * rr, bf_hi(b.x) * rr, bf_lo(b.y) * rr, bf_hi(b.y) * rr); o.w = pg8::pk4_fp8(bf_lo(b.z) * rr, bf_hi(b.z) * rr, bf_lo(b.w) * rr, bf_hi(b.w) * rr);
                    ((u32x4*)((unsigned char*)WSP(bf16, WS_AP) + (size_t)gsl[q] * D))[F.lane] = o; } }
            __syncthreads();
            if (F.tid < 8) lc[F.tid] = 0u;
            __syncthreads();
        }
    }
    SEAM(PH_GATHER);
    if (IN(PH_MOE1) || IN(PH_MOE2)) { PH_BEGIN();
        pg8::MoeOrder S; int tot = 0;
#pragma unroll
        for (int e = 0; e < 8; ++e) { tot += (int)((__hip_atomic_load(F.ctl + CW_CNT + 64 * e, RLX_AGENT) + 255u) >> 8); S.tend[e] = tot; }
        if (IN(PH_MOE1)) for (int rep_ = 0; rep_ < REPS(PH_MOE1); ++rep_) { PH_BEGIN();
            pg8::Gemm g{WSP(bf16, WS_AP), WSP(bf16, WS_W_GU1), D / 2, D / 2}; S.so.init(tot, 28, F.G, bx);
            pg8::EpiSwiGLUFold E{(unsigned char*)WSP(bf16, WS_HP), FF, 28};
            pg8::gemm_phase<pg8::EpiSwiGLUFold, pg8::MoeOrder, true, true, false>(F.tid, ring, g, S, E);
        }
        SEAM(PH_MOE1);
        if (IN(PH_MOE2)) for (int rep_ = 0; rep_ < REPS(PH_MOE2); ++rep_) { PH_BEGIN();
            pg8::Gemm g{WSP(bf16, WS_HP), WSP(bf16, WS_W_D1), FF / 2, FF / 2}; S.so.init(tot, 4, F.G, bx);
#if YP_FP8
            pg8::EpiScaleF8<0> E{F.ws + WS_YP, 1024, pg8::RowScaleT<0>{WSP(float, WS_SLOT_GATE), 0.f}, 4};
            pg8::gemm_phase<pg8::EpiScaleF8<0>, pg8::MoeOrder, true, true, false>(F.tid, ring, g, S, E);
#else
            pg8::EpiScaleBf16<0> E{WSP(bf16, WS_YP), 1024, pg8::RowScaleT<0>{WSP(float, WS_SLOT_GATE), 0.f}, 4};
            pg8::gemm_phase<pg8::EpiScaleBf16<0>, pg8::MoeOrder, true, true, false>(F.tid, ring, g, S, E);
#endif
        }
    }
    SEAM(PH_MOE2);
    if (IN(PH_COMBINE)) for (int rep_ = 0; rep_ < REPS(PH_COMBINE); ++rep_) { PH_BEGIN();
#if YP_FP8
        u32x2 sn = (u32x2){0u, 0u}, xn[4]; unsigned an[4], bn[4];
#define CMB_SLOTS(m_) (*(const u32x2*)(WSP(unsigned, WS_TOK_SLOT) + (size_t)(m_) * 2))
#define CMB_ROWS(m_, sl_) do { const u32x2* xr_ = (const u32x2*)(WSP(bf16, WS_XB) + (size_t)(m_) * D) + F.lane; const unsigned* y1_ = (const unsigned*)(F.ws + WS_YP + (size_t)(sl_).x * D) + F.lane; const unsigned* y2_ = (const unsigned*)(F.ws + WS_YP + (size_t)(sl_).y * D) + F.lane; \
            _Pragma("unroll") for (int j_ = 0; j_ < 4; ++j_) { xn[j_] = __builtin_nontemporal_load(xr_ + 64 * j_); an[j_] = __builtin_nontemporal_load(y1_ + 64 * j_); bn[j_] = __builtin_nontemporal_load(y2_ + 64 * j_); } } while (0)
#define CMB_Y(w_, k_) ((k_) < 2 ? __builtin_amdgcn_cvt_pk_f32_fp8((int)(w_), false)[(k_) & 1] : __builtin_amdgcn_cvt_pk_f32_fp8((int)(w_), true)[(k_) & 1])
#else
        u32x2 sn = (u32x2){0u, 0u}, xn[4], an[4], bn[4];
#define CMB_SLOTS(m_) (*(const u32x2*)(WSP(unsigned, WS_TOK_SLOT) + (size_t)(m_) * 2))
#define CMB_ROWS(m_, sl_) do { const u32x2* xr_ = (const u32x2*)(WSP(bf16, WS_XB) + (size_t)(m_) * D) + F.lane; const u32x2* y1_ = (const u32x2*)(WSP(bf16, WS_YP) + (size_t)(sl_).x * D) + F.lane; const u32x2* y2_ = (const u32x2*)(WSP(bf16, WS_YP) + (size_t)(sl_).y * D) + F.lane; \
            _Pragma("unroll") for (int j_ = 0; j_ < 4; ++j_) { xn[j_] = __builtin_nontemporal_load(xr_ + 64 * j_); an[j_] = __builtin_nontemporal_load(y1_ + 64 * j_); bn[j_] = __builtin_nontemporal_load(y2_ + 64 * j_); } } while (0)
#endif
        if (F.gw < T) { const u32x2 s0 = CMB_SLOTS(F.gw); if (F.gw + F.NGW < T) sn = CMB_SLOTS(F.gw + F.NGW); CMB_ROWS(F.gw, s0); }
        for (int m = F.gw; m < T; m += F.NGW) { u32x2 xc[4];
#if YP_FP8
            unsigned ac[4], bc[4];
#else
            u32x2 ac[4], bc[4];
#endif
#pragma unroll
            for (int j = 0; j < 4; ++j) { xc[j] = xn[j]; ac[j] = an[j]; bc[j] = bn[j]; }
            if (m + F.NGW < T) { const u32x2 s1 = sn; if (m + 2 * F.NGW < T) sn = CMB_SLOTS(m + 2 * F.NGW); CMB_ROWS(m + F.NGW, s1); }
            f32x4* o = (f32x4*)(A.out + (size_t)m * D) + F.lane;
#pragma unroll
#if YP_FP8
            for (int j = 0; j < 4; ++j) { const u32x2 xw = xc[j]; const f32x4 xv = (f32x4){bf_lo(xw.x), bf_hi(xw.x), bf_lo(xw.y), bf_hi(xw.y)};
                const f32x2 a0 = __builtin_amdgcn_cvt_pk_f32_fp8((int)ac[j], false), a1 = __builtin_amdgcn_cvt_pk_f32_fp8((int)ac[j], true), b0 = __builtin_amdgcn_cvt_pk_f32_fp8((int)bc[j], false), b1 = __builtin_amdgcn_cvt_pk_f32_fp8((int)bc[j], true);
                __builtin_nontemporal_store((f32x4){xv[0] + (a0.x + b0.x) * 0.0625f, xv[1] + (a0.y + b0.y) * 0.0625f, xv[2] + (a1.x + b1.x) * 0.0625f, xv[3] + (a1.y + b1.y) * 0.0625f}, o + 64 * j); } }
#else
            for (int j = 0; j < 4; ++j) { const u32x2 xw = xc[j]; const f32x4 xv = (f32x4){bf_lo(xw.x), bf_hi(xw.x), bf_lo(xw.y), bf_hi(xw.y)}; const u32x2 a = ac[j], b2 = bc[j];
                __builtin_nontemporal_store((f32x4){xv[0] + bf_lo(a.x) + bf_lo(b2.x), xv[1] + bf_hi(a.x) + bf_hi(b2.x), xv[2] + bf_lo(a.y) + bf_lo(b2.y), xv[3] + bf_hi(a.y) + bf_hi(b2.y)}, o + 64 * j); } }
#endif
#undef CMB_SLOTS
#undef CMB_ROWS
#ifdef CMB_Y
#undef CMB_Y
#endif
    }
    if (IN(PH_DBG)) { PH_BEGIN();
        const size_t NOUT = (size_t)T * D;
        if (A.dbg < 10) { const float* src = (A.dbg == 1) ? WSP(float, WS_XA) : (A.dbg == 2) ? WSP(float, WS_XC) : F32IN(0);
            for (size_t i = (size_t)bx * 512 + F.tid; i < NOUT; i += (size_t)F.G * 512) { const float v = src[i]; A.out[i] = (v - v == 0.f) ? v : 1e3f; } }
        else { const int k = A.dbg - 10; size_t off = WS_XB, n = NOUT;
            if (k == 1) { off = WS_PROJ0; n = (size_t)T * 2560; } if (k == 2) { off = WS_MEMKV; n = (size_t)NMEMROWS * 1024; } if (k == 3) { off = WS_MIX; n = NOUT; }
            if (k == 4) { off = WS_CLOC; n = (size_t)1024 * ML_CROWS * ML_DK; } if (k == 5) { off = WS_W_IN0; n = (size_t)2560 * 1024; } if (k == 6) { off = WS_W_OUT0; n = (size_t)1024 * 1024; }
            if (k == 7) { off = WS_H; n = (size_t)T * FF; } if (k == 8) { off = WS_Z; n = NOUT; } if (k == 9) { off = WS_KVR; n = (size_t)T * 1536; } if (k == 10) { off = WS_QR; n = (size_t)T * 1280; }
            if (k == 11) { off = WS_KF; n = (size_t)T * 6 * 192; } if (k == 12) { off = WS_W_MEM; n = (size_t)1024 * 1024; } if (k == 13) { off = WS_MEMB; n = (size_t)NMEMROWS * 1024; }
            const bf16* buf = WSP(bf16, off); const float* x = F32IN(0);
            for (size_t i = (size_t)bx * 512 + F.tid; i < NOUT; i += (size_t)F.G * 512) { bool bad = false;
                for (size_t j = i; j < n; j += NOUT) { const unsigned short h = buf[j]; bad |= ((h & 0x7f80u) == 0x7f80u); }
                if (k == 17) { bad = false; if (i < (size_t)T * 8) { const float v = WSP(float, WS_IFG)[i]; bad = !(v - v == 0.f) || fabsf(v) > 50.f; } else if (i < (size_t)T * 8 + 2048) { const float v = WSP(float, WS_GLML)[i - (size_t)T * 8]; bad = !(v - v == 0.f) || fabsf(v) > 200.f; } else if (i < (size_t)T * 9 + 2048) { const float v = WSP(float, WS_R0)[i - (size_t)T * 8 - 2048]; bad = !(v - v == 0.f) || v > 2.f || v < 0.5f; } }
                if (k == 15) { const unsigned short h = WSP(bf16, WS_MIX)[i]; bad = ((i & 1023) >= 768) && ((h & 0x7f80u) == 0x7f80u); }
                if (k == 16) { const unsigned short h = WSP(bf16, WS_MIX)[i]; bad = ((i & 1023) < 768) && ((h & 0x7f80u) == 0x7f80u); }
                A.out[i] = x[i] + (bad ? 1e3f : 0.f); } }
    }
#undef IN
#undef SEAM
}

extern "C" void kernel_launch(void* const* d_in, const int* in_sizes, int n_in, void* d_out, int out_size, void* d_ws, size_t ws_size, hipStream_t stream) {
    static int grid = 0;
    if (grid == 0) {
        if (n_in != 29 || out_size != T * D || ws_size < WS_END) { fprintf(stderr, "kernel_launch: unexpected shapes (n_in %d out %d ws %zu)\n", n_in, out_size, ws_size); grid = -1; return; }
        int dev = 0, cus = 0, per_cu = 0;
        if (hipGetDevice(&dev) != hipSuccess || hipDeviceGetAttribute(&cus, hipDeviceAttributeMultiprocessorCount, dev) != hipSuccess) { grid = -1; return; }
        if (hipFuncSetAttribute((const void*)fwd_kernel, hipFuncAttributeMaxDynamicSharedMemorySize, LDS_BYTES) != hipSuccess) { fprintf(stderr, "kernel_launch: hipFuncSetAttribute failed\n"); grid = -1; return; }
        if (hipOccupancyMaxActiveBlocksPerMultiprocessor(&per_cu, (const void*)fwd_kernel, NWAVES * 64, LDS_BYTES) != hipSuccess || per_cu < 1) fprintf(stderr, "kernel_launch: occupancy query says %d\n", per_cu);
        (void)hipGetLastError();
        grid = cus;
    }
    if (grid < 0) return;
    (void)hipMemsetAsync((char*)d_ws + WS_CTL, 0, CTL_ZERO_BYTES, stream);
    Args a{};
    for (int i = 0; i < 29; ++i) a.in[i] = d_in[i];
    a.out = (float*)d_out; a.ws = (unsigned char*)d_ws;
    for (int i = 0; i < 32; ++i) a.inv[i] = (float)pow(10000.0, -(double)i / 32.0);
    a.dbg = DBG_MODE; a.pad = 0;
    const int last = (DBG_MODE != 0) ? DBG_LAST : PH_DBG;
#if MK_ONE_LAUNCH
    if (DBG_MODE == 0) { a.ph_lo = 0; a.ph_hi = PH_DBG; hipLaunchKernelGGL(fwd_kernel, dim3(grid), dim3(NWAVES * 64), LDS_BYTES, stream, a); }
    else { a.ph_lo = 0; a.ph_hi = last; hipLaunchKernelGGL(fwd_kernel, dim3(grid), dim3(NWAVES * 64), LDS_BYTES, stream, a);
           a.ph_lo = PH_DBG; a.ph_hi = PH_DBG + 1; hipLaunchKernelGGL(fwd_kernel, dim3(grid), dim3(NWAVES * 64), LDS_BYTES, stream, a); }
#else
    for (int p = 0; p < last; ++p) { a.ph_lo = p; a.ph_hi = p + 1; hipLaunchKernelGGL(fwd_kernel, dim3(grid), dim3(NWAVES * 64), LDS_BYTES, stream, a); }
    if (DBG_MODE != 0) { a.ph_lo = PH_DBG; a.ph_hi = PH_DBG + 1; hipLaunchKernelGGL(fwd_kernel, dim3(grid), dim3(NWAVES * 64), LDS_BYTES, stream, a); }
#endif
}
```

```cpp
#define MK_ONE_LAUNCH 1
#define FFN2_FP8 1
#define L1_FP8 1
#define KFIN_FUSED 1
#define YP_FP8 1
#define ATT_WSKIP 0
#define PG8_WGM 4
#define MOE_DEP 1
#define MOE_LT_K 3
#define MOE_ROT 128
#define P1_MEMQ 1
#include <hip/hip_runtime.h>
#include <cstdio>
#include <cstdint>
#include <cmath>
#ifndef PG8_WGM
#define PG8_WGM 8
#endif
namespace pg8 {
#define PG8_LAS __attribute__((address_space(3)))
typedef unsigned short bf16_t;
typedef short bf16x8 __attribute__((ext_vector_type(8)));
typedef float f32x4 __attribute__((ext_vector_type(4)));
typedef unsigned u32x4 __attribute__((ext_vector_type(4)));
typedef unsigned u32x2 __attribute__((ext_vector_type(2)));
constexpr int BM = 256, BK = 64, HALF = 128, HTB = HALF * BK * 2  , STAGE_BYTES = 8 * HTB, NXCD = 8, WGM = PG8_WGM;

__host__ __device__ __forceinline__ int lds_byte(int r, int c) { const int st = (r >> 4) * 2 + (c >> 5), rr = r & 15, cc = c & 31, ob = rr * 64 + cc * 2; return st * 1024 + (ob ^ (((ob >> 9) & 1) << 5)); }
__host__ __device__ __forceinline__ void stage_rc(int b, int& R, int& C) { const int st = b / 1024, sb = b % 1024, swz = sb ^ (((sb >> 9) & 1) << 5); R = (st >> 1) * 16 + swz / 64; C = (st & 1) * 32 + (swz % 64) / 2; }
__host__ __device__ __forceinline__ int perm32(int rho) { const int n = rho >> 4, i = rho & 15; return 8 * (i >> 2) + 4 * n + (i & 3); }

struct Unit { int pm, pn; };
struct Gemm { const bf16_t* A; const bf16_t* Bt; int lda; int K; };

struct StaticOrder {
    int nM, nN, nwg, G, c;
    __host__ __device__ void init(int nM_, int nN_, int G_, int c_) { nM = nM_; nN = nN_; nwg = nM * nN; G = G_; c = c_; }
    __host__ __device__ __forceinline__ bool next(int i, Unit& u) const { return next_c(i, c, u); }
    __host__ __device__ __forceinline__ bool next_c(int i, int c_, Unit& u) const {
        const long L = (long)i * G + c_; if (L >= nwg) return false;
        int wgid = (int)L; { const int q = nwg / NXCD, r = nwg % NXCD, xcd = wgid % NXCD, off = wgid / NXCD; wgid = (xcd < r ? xcd * (q + 1) : r * (q + 1) + (xcd - r) * q) + off; }
        const int nig = WGM * nN, gid = wgid / nig, fm = gid * WGM, gsz = (nM - fm) < WGM ? (nM - fm) : WGM;
        u.pm = fm + ((wgid % nig) % gsz); u.pn = (wgid % nig) / gsz; return true;
    }
    __device__ __forceinline__ void a_ready(const Unit&) const {}
    __device__ __forceinline__ void done(const Unit&) const {}
};
struct MoeOrder {
    StaticOrder so; int tend[8]; int r0 = 0, r1 = 0x3fffffff, sw = 0;
    int lt_lo = 0, lt_n = 0, lt_k = 0, lt_r = 0;
    int rot = 0, rot_lim = 0;
    __device__ __forceinline__ bool unit_at(int i, Unit& u) const {
        int c = so.c;
        if (lt_k) { const int d = c - lt_lo;
            if (d >= 0 && d < lt_n) { if (i >= lt_r) return false; }
            else if (d >= lt_n && d < lt_n * (1 + lt_k) && i == lt_r + lt_k) { const int idx = d - lt_n; i = lt_r + idx / lt_n; c = lt_lo + idx % lt_n; } }
        if (i < rot_lim) c = (c + rot) % so.G;
        return so.next_c(i, c, u);
    }
    __device__ __forceinline__ bool next(int i, Unit& u) const {
        i += r0; if (i >= r1) return false; if (sw && i < 2) i ^= 1;
        if (!unit_at(i, u)) return false;
        int e = 0;
#pragma unroll
        for (int k = 0; k < 7; ++k) e += (u.pm >= tend[k]) ? 1 : 0;
        u.pn += e * so.nN; return true;
    }
    __device__ __forceinline__ void a_ready(const Unit&) const {}
    __device__ __forceinline__ void done(const Unit&) const {}
};

typedef __bf16 bf16v2 __attribute__((ext_vector_type(2)));
__device__ __forceinline__ unsigned cvt_pk_bf16(float lo, float hi) { bf16v2 v = {(__bf16)lo, (__bf16)hi}; return __builtin_bit_cast(unsigned, v); }

#ifndef MOE2_A_AUX
#define MOE2_A_AUX 0
#endif
#ifndef MOE2_B_AUX
#define MOE2_B_AUX 0
#endif
#ifndef MOE1_B_AUX
#define MOE1_B_AUX 0
#endif
#ifndef EPI_WT
#define EPI_WT 0
#endif
typedef int i32x4_ __attribute__((ext_vector_type(4))); typedef int i32x2_ __attribute__((ext_vector_type(2)));
template <class V> __device__ __forceinline__ void st_out(void* base, void* p, V v) {
    if constexpr (EPI_WT) { const __amdgpu_buffer_rsrc_t rs = __builtin_amdgcn_make_buffer_rsrc(base, 0, 0x7fffffff, 0x00020000); const int off = (int)((const char*)p - (const char*)base);
        if constexpr (sizeof(V) == 16) __builtin_amdgcn_raw_buffer_store_b128(__builtin_bit_cast(i32x4_, v), rs, off, 0, EPI_WT);
        else __builtin_amdgcn_raw_buffer_store_b64(__builtin_bit_cast(i32x2_, v), rs, off, 0, EPI_WT); }
    else *(V*)p = v;
}
typedef int i32x4 __attribute__((ext_vector_type(4)));
typedef int i32x8 __attribute__((ext_vector_type(8)));
__device__ __forceinline__ i32x8 cat8(bf16x8 a, bf16x8 b) { const i32x4 x = __builtin_bit_cast(i32x4, a), y = __builtin_bit_cast(i32x4, b); return __builtin_shufflevector(x, y, 0, 1, 2, 3, 4, 5, 6, 7); }
template <bool FP8> struct FragT { bf16x8 k[2]; };
template <> struct FragT<true> { i32x8 v; };
template <class Epi, class Sched, bool FP8 = false, bool ALIGN_EPI = true, bool SP2 = true, bool PEEL = !FP8>
__device__ __forceinline__ void gemm_phase(int tid, PG8_LAS unsigned char* lds, const Gemm g, const Sched& S, const Epi& E) {
    asm volatile("" : "+v"(tid));
    const int wid = __builtin_amdgcn_readfirstlane(tid >> 6), lane = tid & 63, wr = wid >> 2, wc = wid & 3, fr = lane & 15, fq = lane >> 4;
    const int K = g.K, nt = K / BK, lda = g.lda;
    unsigned voffA[2], voffB[2];
#pragma unroll
    for (int i = 0; i < 2; ++i) { int R, C; stage_rc(tid * 16 + i * 8192, R, C); const int Rb = Epi::PERM ? ((R & ~31) + perm32(R & 31)) : R;
        voffA[i] = (unsigned)(R * lda + C) * 2u; voffB[i] = (unsigned)(Rb * K + C) * 2u; }
    const unsigned kstep = (unsigned)(BK * 2);
    const unsigned hstepA = (unsigned)HALF * lda * 2u, hstepB = (unsigned)HALF * K * 2u;
    const unsigned tstepA = 2u * hstepA, tstepB = 2u * hstepB;
    const __amdgpu_buffer_rsrc_t rsA = __builtin_amdgcn_make_buffer_rsrc((void*)g.A, 0, 0x7fffffff, 0x00020000), rsB = __builtin_amdgcn_make_buffer_rsrc((void*)g.Bt, 0, 0x7fffffff, 0x00020000);
    const unsigned ldsw = (unsigned)wid * 1024u;
    const int aoff = lds_byte(wr * 64 + fr, fq * 8), boff = lds_byte(wc * 32 + fr, fq * 8);
#define PG8_SA(b, h) (((b) * 2 + (h)) * HTB)
#define PG8_SB(b, h) ((4 + (b) * 2 + (h)) * HTB)
#define PG8_STAGE_(rs, bufoff, soff, voff, aux) do { _Pragma("unroll") for (int _i = 0; _i < 2; ++_i) \
        __builtin_amdgcn_raw_ptr_buffer_load_lds(rs, (PG8_LAS void*)(lds + (bufoff) + ldsw + _i * 8192), 16, (voff)[_i], (soff), 0, aux); } while (0)
#define PG8_STAGEA(bufoff, soff) PG8_STAGE_(rsA, bufoff, soff, voffA, Epi::A_AUX)
#define PG8_STAGEB(bufoff, soff) PG8_STAGE_(rsB, bufoff, soff, voffB, Epi::B_AUX)
#define PG8_LDF(dst, base) do { if constexpr (FP8) { (dst).v.lo = *(const PG8_LAS i32x4*)(base); (dst).v.hi = *(const PG8_LAS i32x4*)((base) + 1024); } \
        else { (dst).k[0] = *(const PG8_LAS bf16x8*)(base); (dst).k[1] = *(const PG8_LAS bf16x8*)((base) + 1024); } } while (0)
#define PG8_LDA(dst, b, h) do { _Pragma("unroll") for (int m = 0; m < 4; ++m) PG8_LDF(dst[m], lds + PG8_SA(b, h) + aoff + m * 2048); } while (0)
#define PG8_LDB(dst, b, h) do { _Pragma("unroll") for (int n = 0; n < 2; ++n) PG8_LDF(dst[n], lds + PG8_SB(b, h) + boff + n * 2048); } while (0)
#define PG8_MMA_(ai, bj, At, Bt, CIN) do { __builtin_amdgcn_s_setprio(1); _Pragma("unroll") for (int m = 0; m < 4; ++m) _Pragma("unroll") for (int n = 0; n < 2; ++n) { \
        if constexpr (FP8) acc[ai][bj][m][n] = __builtin_amdgcn_mfma_scale_f32_16x16x128_f8f6f4(Bt[n].v, At[m].v, CIN, 0, 0, 0, (int)Epi::WSCALE, 0, 0x7F7F7F7F); \
        else { acc[ai][bj][m][n] = __builtin_amdgcn_mfma_f32_16x16x32_bf16(Bt[n].k[0], At[m].k[0], CIN, 0, 0, 0); acc[ai][bj][m][n] = __builtin_amdgcn_mfma_f32_16x16x32_bf16(Bt[n].k[1], At[m].k[1], acc[ai][bj][m][n], 0, 0, 0); } } \
        __builtin_amdgcn_s_setprio(0); } while (0)
#define PG8_MMA(ai, bj, At, Bt) PG8_MMA_(ai, bj, At, Bt, acc[ai][bj][m][n])
#define PG8_MMAZ(ai, bj, At, Bt) do { if constexpr (!PEEL) PG8_MMA_(ai, bj, At, Bt, acc[ai][bj][m][n]); else PG8_MMA_(ai, bj, At, Bt, zero4); } while (0)
#define PG8_WAIT_V(n) asm volatile("s_waitcnt vmcnt(" #n ")" ::: "memory")
#define PG8_WAIT_L(n) asm volatile("s_waitcnt lgkmcnt(" #n ")" ::: "memory")
#define PG8_BAR __builtin_amdgcn_s_barrier()
#define PG8_SCHED __builtin_amdgcn_sched_barrier(0)
    Unit cur, nxt; int ui = 0;
    if (!S.next(0, cur)) return;
    f32x4 acc[2][2][4][2];
    if constexpr (!PEEL) {
#pragma unroll
    for (int a = 0; a < 2; ++a)
#pragma unroll
            for (int b = 0; b < 2; ++b)
#pragma unroll
                for (int m = 0; m < 4; ++m)
#pragma unroll
                    for (int n = 0; n < 2; ++n) acc[a][b][m][n] = (f32x4){0.f, 0.f, 0.f, 0.f};
    }
    FragT<FP8> At[4], B0[2], B1[2]; const f32x4 zero4 = (f32x4){0.f, 0.f, 0.f, 0.f};
    unsigned cA = (unsigned)cur.pm * tstepA, cB = (unsigned)cur.pn * tstepB;
    S.a_ready(cur);
    if constexpr (SP2) {
        PG8_STAGEB(PG8_SB(0, 0), cB); PG8_STAGEB(PG8_SB(0, 1), cB + hstepB); PG8_STAGEA(PG8_SA(0, 0), cA); PG8_STAGEA(PG8_SA(0, 1), cA + hstepA);
        if (wr == 1) PG8_BAR;
        PG8_WAIT_V(2); PG8_BAR;
        PG8_STAGEB(PG8_SB(1, 0), cB + kstep); PG8_STAGEA(PG8_SA(1, 0), cA + kstep); PG8_STAGEB(PG8_SB(1, 1), cB + hstepB + kstep);
        PG8_WAIT_V(6); PG8_BAR;
    } else {
        PG8_STAGEB(PG8_SB(0, 0), cB); PG8_STAGEA(PG8_SA(0, 0), cA); PG8_STAGEB(PG8_SB(0, 1), cB + hstepB); PG8_STAGEA(PG8_SA(0, 1), cA + hstepA);
        if (wr == 1) PG8_BAR;
        PG8_WAIT_V(4); PG8_BAR;
        PG8_STAGEB(PG8_SB(1, 0), cB + kstep); PG8_STAGEA(PG8_SA(1, 0), cA + kstep); PG8_STAGEB(PG8_SB(1, 1), cB + hstepB + kstep);
        PG8_WAIT_V(6); PG8_BAR;
    }
    for (;;) {
        const bool has_next = S.next(ui + 1, nxt);
        const unsigned nA = has_next ? (unsigned)nxt.pm * tstepA : cA, nB = has_next ? (unsigned)nxt.pn * tstepB : cB;
        if constexpr (PEEL) { const int t = 0;
            const unsigned a1 = cA + (unsigned)(t + 1) * kstep;
            const unsigned a2 = cA + (unsigned)(t + 2) * kstep, b2 = cB + (unsigned)(t + 2) * kstep;
            const unsigned a3 = a2 + kstep, b3 = b2 + kstep;
            if constexpr (SP2) {
            PG8_LDB(B0, 0, 0); PG8_LDB(B1, 0, 1); PG8_SCHED; PG8_LDA(At, 0, 0); PG8_STAGEA(PG8_SA(1, 1), a1 + hstepA);
            PG8_WAIT_V(8); PG8_WAIT_L(0); PG8_BAR; PG8_SCHED; PG8_MMAZ(0, 0, At, B0); PG8_MMAZ(0, 1, At, B1); PG8_BAR; PG8_SCHED;
            PG8_LDA(At, 0, 1); PG8_STAGEB(PG8_SB(0, 0), b2); PG8_STAGEB(PG8_SB(0, 1), b2 + hstepB); PG8_STAGEA(PG8_SA(0, 0), a2);
            PG8_WAIT_V(8); PG8_WAIT_L(0); PG8_BAR; PG8_SCHED; PG8_MMAZ(1, 0, At, B0); PG8_MMAZ(1, 1, At, B1); PG8_BAR; PG8_SCHED;
            PG8_LDB(B0, 1, 0); PG8_LDB(B1, 1, 1); PG8_SCHED; PG8_LDA(At, 1, 0); PG8_STAGEA(PG8_SA(0, 1), a2 + hstepA);
            PG8_WAIT_V(8); PG8_WAIT_L(0); PG8_BAR; PG8_SCHED; PG8_MMA(0, 0, At, B0); PG8_MMA(0, 1, At, B1); PG8_BAR; PG8_SCHED;
            PG8_LDA(At, 1, 1); PG8_STAGEB(PG8_SB(1, 0), b3); PG8_STAGEB(PG8_SB(1, 1), b3 + hstepB); PG8_STAGEA(PG8_SA(1, 0), a3);
            PG8_WAIT_V(8); PG8_WAIT_L(0); PG8_BAR; PG8_SCHED; PG8_MMA(1, 0, At, B0); PG8_MMA(1, 1, At, B1); PG8_BAR; PG8_SCHED;
            } else {
            PG8_LDB(B0, 0, 0); PG8_SCHED; PG8_LDA(At, 0, 0); PG8_STAGEA(PG8_SA(1, 1), a1 + hstepA);
            PG8_WAIT_L(8); PG8_BAR; PG8_WAIT_L(0); PG8_MMAZ(0, 0, At, B0); PG8_BAR; PG8_SCHED;
            PG8_LDB(B1, 0, 1); PG8_STAGEB(PG8_SB(0, 0), b2);
            PG8_BAR; PG8_WAIT_L(0); PG8_MMAZ(0, 1, At, B1); PG8_BAR;
            PG8_LDA(At, 0, 1); PG8_STAGEA(PG8_SA(0, 0), a2);
            PG8_BAR; PG8_WAIT_L(0); PG8_MMAZ(1, 0, At, B0); PG8_BAR; PG8_SCHED;
            PG8_STAGEB(PG8_SB(0, 1), b2 + hstepB);
            PG8_WAIT_V(6); PG8_BAR; PG8_MMAZ(1, 1, At, B1); PG8_BAR;
            PG8_LDB(B0, 1, 0); PG8_SCHED; PG8_LDA(At, 1, 0); PG8_STAGEA(PG8_SA(0, 1), a2 + hstepA);
            PG8_WAIT_L(8); PG8_BAR; PG8_WAIT_L(0); PG8_MMA(0, 0, At, B0); PG8_BAR; PG8_SCHED;
            PG8_LDB(B1, 1, 1); PG8_STAGEB(PG8_SB(1, 0), b3);
            PG8_BAR; PG8_WAIT_L(0); PG8_MMA(0, 1, At, B1); PG8_BAR;
            PG8_LDA(At, 1, 1); PG8_STAGEA(PG8_SA(1, 0), a3);
            PG8_BAR; PG8_WAIT_L(0); PG8_MMA(1, 0, At, B0); PG8_BAR; PG8_SCHED;
            PG8_STAGEB(PG8_SB(1, 1), b3 + hstepB);
            PG8_WAIT_V(6); PG8_BAR; PG8_MMA(1, 1, At, B1); PG8_BAR;
            }
        }
#pragma unroll 1
        for (int t = PEEL ? 2 : 0; t < nt; t += 2) {
            const bool last = (t == nt - 2);
            const unsigned a1 = cA + (unsigned)(t + 1) * kstep;
            const unsigned a2 = last ? nA : cA + (unsigned)(t + 2) * kstep, b2 = last ? nB : cB + (unsigned)(t + 2) * kstep;
            const unsigned a3 = a2 + kstep, b3 = b2 + kstep;
            if (last && has_next) S.a_ready(nxt);
            if constexpr (SP2) {
            PG8_LDB(B0, 0, 0); PG8_LDB(B1, 0, 1); PG8_SCHED; PG8_LDA(At, 0, 0); PG8_STAGEA(PG8_SA(1, 1), a1 + hstepA);
            PG8_WAIT_V(8); PG8_WAIT_L(0); PG8_BAR; PG8_SCHED; PG8_MMA(0, 0, At, B0); PG8_MMA(0, 1, At, B1); PG8_BAR; PG8_SCHED;
            PG8_LDA(At, 0, 1); PG8_STAGEB(PG8_SB(0, 0), b2); PG8_STAGEB(PG8_SB(0, 1), b2 + hstepB); PG8_STAGEA(PG8_SA(0, 0), a2);
            PG8_WAIT_V(8); PG8_WAIT_L(0); PG8_BAR; PG8_SCHED; PG8_MMA(1, 0, At, B0); PG8_MMA(1, 1, At, B1); PG8_BAR; PG8_SCHED;
            PG8_LDB(B0, 1, 0); PG8_LDB(B1, 1, 1); PG8_SCHED; PG8_LDA(At, 1, 0); PG8_STAGEA(PG8_SA(0, 1), a2 + hstepA);
            PG8_WAIT_V(8); PG8_WAIT_L(0); PG8_BAR; PG8_SCHED; PG8_MMA(0, 0, At, B0); PG8_MMA(0, 1, At, B1); PG8_BAR; PG8_SCHED;
            PG8_LDA(At, 1, 1); PG8_STAGEB(PG8_SB(1, 0), b3); PG8_STAGEB(PG8_SB(1, 1), b3 + hstepB); PG8_STAGEA(PG8_SA(1, 0), a3);
            PG8_WAIT_V(8); PG8_WAIT_L(0); PG8_BAR; PG8_SCHED; PG8_MMA(1, 0, At, B0); PG8_MMA(1, 1, At, B1); PG8_BAR; PG8_SCHED;
            } else {
            PG8_LDB(B0, 0, 0); PG8_SCHED; PG8_LDA(At, 0, 0); PG8_STAGEA(PG8_SA(1, 1), a1 + hstepA);
            PG8_WAIT_L(8); PG8_BAR; PG8_WAIT_L(0); PG8_MMA(0, 0, At, B0); PG8_BAR; PG8_SCHED;
            PG8_LDB(B1, 0, 1); PG8_STAGEB(PG8_SB(0, 0), b2);
            PG8_BAR; PG8_WAIT_L(0); PG8_MMA(0, 1, At, B1); PG8_BAR;
            PG8_LDA(At, 0, 1); PG8_STAGEA(PG8_SA(0, 0), a2);
            PG8_BAR; PG8_WAIT_L(0); PG8_MMA(1, 0, At, B0); PG8_BAR; PG8_SCHED;
            PG8_STAGEB(PG8_SB(0, 1), b2 + hstepB);
            PG8_WAIT_V(6); PG8_BAR; PG8_MMA(1, 1, At, B1); PG8_BAR;
            PG8_LDB(B0, 1, 0); PG8_SCHED; PG8_LDA(At, 1, 0); PG8_STAGEA(PG8_SA(0, 1), a2 + hstepA);
            PG8_WAIT_L(8); PG8_BAR; PG8_WAIT_L(0); PG8_MMA(0, 0, At, B0); PG8_BAR; PG8_SCHED;
            PG8_LDB(B1, 1, 1); PG8_STAGEB(PG8_SB(1, 0), b3);
            PG8_BAR; PG8_WAIT_L(0); PG8_MMA(0, 1, At, B1); PG8_BAR;
            PG8_LDA(At, 1, 1); PG8_STAGEA(PG8_SA(1, 0), a3);
            PG8_BAR; PG8_WAIT_L(0); PG8_MMA(1, 0, At, B0); PG8_BAR; PG8_SCHED;
            PG8_STAGEB(PG8_SB(1, 1), b3 + hstepB);
            PG8_WAIT_V(6); PG8_BAR; PG8_MMA(1, 1, At, B1); PG8_BAR;
            }
        }
        if constexpr (ALIGN_EPI) { if (wr == 0) PG8_BAR; }
        { int fr_ = fr, fq_ = fq; asm volatile("" : "+v"(fr_), "+v"(fq_));
          E(acc, cur, wr, wc, fr_, fq_); } S.done(cur);
        if (!has_next) break;
        if constexpr (!PEEL) {
#pragma unroll
        for (int a = 0; a < 2; ++a)
#pragma unroll
            for (int b = 0; b < 2; ++b)
#pragma unroll
                for (int m = 0; m < 4; ++m)
#pragma unroll
                    for (int n = 0; n < 2; ++n) acc[a][b][m][n] = (f32x4){0.f, 0.f, 0.f, 0.f};
        }
        cur = nxt; cA = nA; cB = nB; ++ui;
        if constexpr (ALIGN_EPI) { if (wr == 1) PG8_BAR; }
    }
    PG8_WAIT_V(0);
    if constexpr (!ALIGN_EPI) { if (wr == 0) PG8_BAR; }
    PG8_BAR;
#undef PG8_SA
#undef PG8_SB
#undef PG8_STAGE_
#undef PG8_STAGEA
#undef PG8_STAGEB
#undef PG8_LDA
#undef PG8_LDB
#undef PG8_MMA
#undef PG8_MMA_
#undef PG8_MMAZ
#undef PG8_WAIT_V
#undef PG8_WAIT_L
#undef PG8_BAR
#undef PG8_SCHED
}

__device__ __forceinline__ float shx(float v, int mask, int fr, int fq) { return __builtin_bit_cast(float, __builtin_amdgcn_ds_bpermute((((fq << 4) | fr) ^ mask) << 2, __builtin_bit_cast(int, v))); }
__device__ __forceinline__ float add_x16(float v) { auto rr = __builtin_amdgcn_permlane16_swap(__float_as_uint(v), __float_as_uint(v), false, false); return __uint_as_float(rr[0]) + __uint_as_float(rr[1]); }
__device__ __forceinline__ float add_x32(float v) { auto rr = __builtin_amdgcn_permlane32_swap(__float_as_uint(v), __float_as_uint(v), false, false); return __uint_as_float(rr[0]) + __uint_as_float(rr[1]); }
template <int NSS> struct RowScaleT {
    const float* p; float inv_dim;
    __device__ __forceinline__ float get(int row, int fq, int fr = 0) const {
        if constexpr (NSS == 0) return p[row];
        else { constexpr int NCH = NSS / 4; const f32x4 v = *(const f32x4*)(p + (size_t)row * NSS + 4 * (fq % NCH));
            float s = (v[0] + v[1]) + (v[2] + v[3]);
            if constexpr (NCH >= 2) s = add_x16(s);
            if constexpr (NCH >= 4) s = add_x32(s);
            return __builtin_amdgcn_rsqf(s * inv_dim + 1e-6f); }
    }
};
template <int NSS> struct EpiScaleBf16 {
    static constexpr bool PERM = true; static constexpr unsigned WSCALE = 0x7F7F7F7Fu; static constexpr int A_AUX = 0, B_AUX = 0;
    bf16_t* O; int ldc; RowScaleT<NSS> R; int ntmod;
    __device__ __forceinline__ void operator()(const f32x4 (&acc)[2][2][4][2], const Unit& u, int wr, int wc, int fr, int fq) const {
        const int row0 = u.pm * BM + wr * 64 + fr, col0 = (u.pn % ntmod) * BM + wc * 32 + 8 * fq;
        float sc[2][4];
#pragma unroll
        for (int ai = 0; ai < 2; ++ai)
#pragma unroll
            for (int m = 0; m < 4; ++m) sc[ai][m] = R.get(row0 + ai * HALF + m * 16, fq, fr);
#pragma unroll
        for (int ai = 0; ai < 2; ++ai)
#pragma unroll
            for (int m = 0; m < 4; ++m) { const int row = row0 + ai * HALF + m * 16; const float s = sc[ai][m]; bf16_t* rowp = O + (size_t)row * ldc + col0;
#pragma unroll
                for (int bj = 0; bj < 2; ++bj) { const f32x4 v0 = acc[ai][bj][m][0] * s, v1 = acc[ai][bj][m][1] * s;
                    u32x4 w; w.x = cvt_pk_bf16(v0[0], v0[1]); w.y = cvt_pk_bf16(v0[2], v0[3]); w.z = cvt_pk_bf16(v1[0], v1[1]); w.w = cvt_pk_bf16(v1[2], v1[3]);
                    st_out(O, rowp + bj * HALF, w); } }
    }
};
__device__ __forceinline__ unsigned pk4_fp8(float a, float b, float c, float d) { unsigned w = 0u; a = __builtin_amdgcn_fmed3f(a, -448.f, 448.f); b = __builtin_amdgcn_fmed3f(b, -448.f, 448.f); c = __builtin_amdgcn_fmed3f(c, -448.f, 448.f); d = __builtin_amdgcn_fmed3f(d, -448.f, 448.f);
    w = __builtin_amdgcn_cvt_pk_fp8_f32(a, b, w, false); w = __builtin_amdgcn_cvt_pk_fp8_f32(c, d, w, true); return w; }
__device__ __forceinline__ unsigned pk4_fp8_ns(float a, float b, float c, float d) { unsigned w = 0u; w = __builtin_amdgcn_cvt_pk_fp8_f32(a, b, w, false); w = __builtin_amdgcn_cvt_pk_fp8_f32(c, d, w, true); return w; }
template <int NSS> struct EpiScaleF8 {
    static constexpr bool PERM = true; static constexpr unsigned WSCALE = 0x7F7F7F7Fu; static constexpr int A_AUX = MOE2_A_AUX, B_AUX = MOE2_B_AUX;
    unsigned char* O; int ldc; RowScaleT<NSS> R; int ntmod;
    __device__ __forceinline__ void operator()(const f32x4 (&acc)[2][2][4][2], const Unit& u, int wr, int wc, int fr, int fq) const {
        const int row0 = u.pm * BM + wr * 64 + fr, col0 = (u.pn % ntmod) * BM + wc * 32 + 8 * fq;
        float sc[2][4];
#pragma unroll
        for (int ai = 0; ai < 2; ++ai)
#pragma unroll
            for (int m = 0; m < 4; ++m) sc[ai][m] = R.get(row0 + ai * HALF + m * 16, fq, fr);
#pragma unroll
        for (int ai = 0; ai < 2; ++ai)
#pragma unroll
            for (int m = 0; m < 4; ++m) { const int row = row0 + ai * HALF + m * 16; const float s = sc[ai][m]; unsigned char* rowp = O + (size_t)row * ldc + col0;
#pragma unroll
                for (int bj = 0; bj < 2; ++bj) { const f32x4 v0 = acc[ai][bj][m][0] * s, v1 = acc[ai][bj][m][1] * s;
                    u32x2 w; w.x = pk4_fp8(v0[0], v0[1], v0[2], v0[3]); w.y = pk4_fp8(v1[0], v1[1], v1[2], v1[3]);
                    st_out(O, rowp + bj * HALF, w); } }
    }
};
struct EpiKvUp {
    static constexpr bool PERM = true; static constexpr unsigned WSCALE = 0x7F7F7F7Fu; static constexpr int A_AUX = 0, B_AUX = 0;
    bf16_t* O; int ldc; RowScaleT<4> R; const bf16_t* Z; const float* rope; const float* kg; bf16_t* KF; int seq_log2;
    __device__ __forceinline__ void operator()(const f32x4 (&acc)[2][2][4][2], const Unit& u, int wr, int wc, int fr, int fq) const {
        { const int row0 = u.pm * BM + wr * 64 + fr, col0 = u.pn * BM + wc * 32 + 8 * fq;
          float sc[2][4];
#pragma unroll
          for (int ai = 0; ai < 2; ++ai)
#pragma unroll
              for (int m = 0; m < 4; ++m) sc[ai][m] = R.get(row0 + ai * HALF + m * 16, fq, fr);
#pragma unroll
          for (int ai = 0; ai < 2; ++ai)
#pragma unroll
              for (int m = 0; m < 4; ++m) { const int row = row0 + ai * HALF + m * 16; const float s = sc[ai][m]; bf16_t* rowp = O + (size_t)row * ldc + col0;
#pragma unroll
                  for (int bj = 0; bj < 2; ++bj) { const f32x4 v0 = acc[ai][bj][m][0] * s, v1 = acc[ai][bj][m][1] * s;
                      u32x4 w; w.x = cvt_pk_bf16(v0[0], v0[1]); w.y = cvt_pk_bf16(v0[2], v0[3]); w.z = cvt_pk_bf16(v1[0], v1[1]); w.w = cvt_pk_bf16(v1[2], v1[3]);
                      *(u32x4*)(rowp + bj * HALF) = w; } } }
        asm volatile("s_waitcnt vmcnt(0)" ::: "memory"); __builtin_amdgcn_s_barrier(); asm volatile("" ::: "memory");
        typedef float f32x2 __attribute__((ext_vector_type(2)));
        const int lane = (fq << 4) | fr, wave = wr * 4 + wc, h = u.pn;
        const float gr = kg[128 + lane]; const f32x2 gn = *(const f32x2*)(kg + 2 * lane);
        unsigned wv[2][8], kv[2][8]; f32x2 cs[2][8];
#define KF_LOAD(set_, i0_) do { _Pragma("unroll") for (int q = 0; q < 8; ++q) { const size_t row = (size_t)u.pm * BM + wave * 32 + (i0_) + q; \
            wv[set_][q] = *(const unsigned*)(O + row * ldc + h * BM + 2 * lane); kv[set_][q] = (unsigned)Z[row * 1024 + 640 + lane]; cs[set_][q] = *(const f32x2*)(rope + (row * 32 + (lane & 31)) * 2); } } while (0)
        KF_LOAD(0, 0);
#pragma unroll
        for (int bt = 0; bt < 4; ++bt) { const int i0 = bt * 8, st = bt & 1;
            if (bt < 3) KF_LOAD((bt + 1) & 1, i0 + 8);
#pragma unroll
            for (int q = 0; q < 8; ++q) { const int row = u.pm * BM + wave * 32 + i0 + q, b = row >> seq_log2, sq = row & ((1 << seq_log2) - 1); const int seq = 1 << seq_log2;
                const float a = __uint_as_float(wv[st][q] << 16), c2 = __uint_as_float(wv[st][q] & 0xffff0000u), kr = __uint_as_float(kv[st][q] << 16);
                float ss = a * a + c2 * c2 + kr * kr;
                ss += __builtin_bit_cast(float, __builtin_amdgcn_update_dpp(0, __builtin_bit_cast(int, ss), 0xB1, 0xF, 0xF, true));
                ss += __builtin_bit_cast(float, __builtin_amdgcn_update_dpp(0, __builtin_bit_cast(int, ss), 0x4E, 0xF, 0xF, true));
                ss += __builtin_bit_cast(float, __builtin_amdgcn_update_dpp(0, __builtin_bit_cast(int, ss), 0x141, 0xF, 0xF, true));
                ss += __builtin_bit_cast(float, __builtin_amdgcn_update_dpp(0, __builtin_bit_cast(int, ss), 0x140, 0xF, 0xF, true));
                { auto rr = __builtin_amdgcn_permlane16_swap(__float_as_uint(ss), __float_as_uint(ss), false, false); ss = __uint_as_float(rr[0]) + __uint_as_float(rr[1]); }
                { auto rr = __builtin_amdgcn_permlane32_swap(__float_as_uint(ss), __float_as_uint(ss), false, false); ss = __uint_as_float(rr[0]) + __uint_as_float(rr[1]); }
                const float rk = __builtin_amdgcn_rsqf(ss * (1.0f / 192) + 1e-6f);
                bf16_t* ko = KF + ((size_t)(b * 6 + h) * seq + sq) * 192;
                *(unsigned*)(ko + 2 * lane) = cvt_pk_bf16(a * rk * gn.x, c2 * rk * gn.y);
                const float y = kr * rk * gr; float yp; { auto rr = __builtin_amdgcn_permlane32_swap(__float_as_uint(y), __float_as_uint(y), false, false); yp = __uint_as_float(lane < 32 ? rr[1] : rr[0]); } const float o_ = (lane < 32) ? (y * cs[st][q].x - yp * cs[st][q].y) : (y * cs[st][q].x + yp * cs[st][q].y);
                ko[128 + lane] = (bf16_t)(cvt_pk_bf16(o_, 0.f) & 0xffffu); } }
#undef KF_LOAD
    }
};
struct EpiResidual {
    static constexpr bool PERM = true; static constexpr unsigned WSCALE = 0x7F7F7F7Fu; static constexpr int A_AUX = 0, B_AUX = 0;
    const float* Xin; float* Xout; bf16_t* XB; float* SS; int ldc;
    __device__ __forceinline__ void operator()(const f32x4 (&acc)[2][2][4][2], const Unit& u, int wr, int wc, int fr, int fq) const {
        const int row0 = u.pm * BM + wr * 64 + fr, col0 = u.pn * BM + wc * 32 + 8 * fq;
#pragma unroll
        for (int ai = 0; ai < 2; ++ai)
#pragma unroll
            for (int m = 0; m < 4; ++m) { const int row = row0 + ai * HALF + m * 16; const size_t off = (size_t)row * ldc + col0; float q = 0.f;
#pragma unroll
                for (int bj = 0; bj < 2; ++bj) {
                    const f32x4 x0 = *(const f32x4*)(Xin + off + bj * HALF), x1 = *(const f32x4*)(Xin + off + bj * HALF + 4);
                    const f32x4 v0 = x0 + acc[ai][bj][m][0], v1 = x1 + acc[ai][bj][m][1];
                    *(f32x4*)(Xout + off + bj * HALF) = v0; *(f32x4*)(Xout + off + bj * HALF + 4) = v1;
                    u32x4 w; w.x = cvt_pk_bf16(v0[0], v0[1]); w.y = cvt_pk_bf16(v0[2], v0[3]); w.z = cvt_pk_bf16(v1[0], v1[1]); w.w = cvt_pk_bf16(v1[2], v1[3]);
                    *(u32x4*)(XB + off + bj * HALF) = w;
                    q += (v0[0] * v0[0] + v0[1] * v0[1]) + (v0[2] * v0[2] + v0[3] * v0[3]) + (v1[0] * v1[0] + v1[1] * v1[1]) + (v1[2] * v1[2] + v1[3] * v1[3]); }
                q = add_x16(q); q = add_x32(q);
                if (fq == 0) SS[(size_t)row * 16 + u.pn * 4 + wc] = q; }
    }
};
template <unsigned WS_ = 0x7F7F7F7Fu, int MB = 4, bool W8 = false> struct EpiResidualBf16T {
    static constexpr bool PERM = true; static constexpr unsigned WSCALE = WS_; static constexpr int A_AUX = 0, B_AUX = 0;
    bf16_t* XB; float* SS; int ldc; unsigned char* X8;
    __device__ __forceinline__ void operator()(const f32x4 (&acc)[2][2][4][2], const Unit& u, int wr, int wc, int fr, int fq) const {
        const int row0 = u.pm * BM + wr * 64 + fr, col0 = u.pn * BM + wc * 32 + 8 * fq;
#pragma unroll
        for (int ai = 0; ai < 2; ++ai)
#pragma unroll
          for (int mb = 0; mb < 4; mb += MB) {
            u32x4 xw[MB][2];
#pragma unroll
            for (int mm = 0; mm < MB; ++mm)
#pragma unroll
                for (int bj = 0; bj < 2; ++bj) xw[mm][bj] = *(const u32x4*)(XB + (size_t)(row0 + ai * HALF + (mb + mm) * 16) * ldc + col0 + bj * HALF);
#pragma unroll
            for (int mm = 0; mm < MB; ++mm) { const int m = mb + mm; const int row = row0 + ai * HALF + m * 16; bf16_t* rowp = XB + (size_t)row * ldc + col0; float q = 0.f;
#pragma unroll
                for (int bj = 0; bj < 2; ++bj) { float v[8];
#pragma unroll
                    for (int j = 0; j < 4; ++j) { v[2 * j] = __uint_as_float(xw[mm][bj][j] << 16) + acc[ai][bj][m][j >> 1][(2 * j) & 3]; v[2 * j + 1] = __uint_as_float(xw[mm][bj][j] & 0xffff0000u) + acc[ai][bj][m][j >> 1][(2 * j + 1) & 3]; }
                    u32x4 w; w.x = cvt_pk_bf16(v[0], v[1]); w.y = cvt_pk_bf16(v[2], v[3]); w.z = cvt_pk_bf16(v[4], v[5]); w.w = cvt_pk_bf16(v[6], v[7]);
                    st_out(XB, rowp + bj * HALF, w);
                    if constexpr (W8) { u32x2 w8; w8.x = pk4_fp8_ns(v[0], v[1], v[2], v[3]); w8.y = pk4_fp8_ns(v[4], v[5], v[6], v[7]); st_out(X8, X8 + (size_t)row * ldc + col0 + bj * HALF, w8); }
#pragma unroll
                    for (int j = 0; j < 8; ++j) q += v[j] * v[j]; }
                q = add_x16(q); q = add_x32(q);
                if (fq == 0) SS[(size_t)row * 16 + u.pn * 4 + wc] = q; } }
    }
};
typedef EpiResidualBf16T<> EpiResidualBf16;
template <bool F8OUT, int NSS> struct EpiSwiGLU {
    static constexpr bool PERM = true; static constexpr unsigned WSCALE = 0x7F7F7F7Fu; static constexpr int A_AUX = 0, B_AUX = 0;
    bf16_t* H; int ldh; RowScaleT<NSS> R; int ntmod; float hscale;
    __device__ __forceinline__ void operator()(const f32x4 (&acc)[2][2][4][2], const Unit& u, int wr, int wc, int fr, int fq) const {
        const int row0 = u.pm * BM + wr * 64 + fr, col0 = (u.pn % ntmod) * HALF + wc * 32 + 8 * fq;
        float sc[2][4];
#pragma unroll
        for (int ai = 0; ai < 2; ++ai)
#pragma unroll
            for (int m = 0; m < 4; ++m) sc[ai][m] = R.get(row0 + ai * HALF + m * 16, fq, fr);
#pragma unroll
        for (int ai = 0; ai < 2; ++ai)
#pragma unroll
            for (int m = 0; m < 4; ++m) { const int row = row0 + ai * HALF + m * 16; const float s = sc[ai][m];
                float h[8]; const float sneg = -1.4426950408889634f * s, s2h = s * s * hscale;
                typedef float f32x2 __attribute__((ext_vector_type(2)));
#pragma unroll
                for (int n = 0; n < 2; ++n)
#pragma unroll
                    for (int j = 0; j < 4; j += 2) { const f32x2 ag = {acc[ai][0][m][n][j], acc[ai][0][m][n][j + 1]}, au = {acc[ai][1][m][n][j], acc[ai][1][m][n][j + 1]};
                        const f32x2 t = ag * sneg; f32x2 e; e.x = __builtin_amdgcn_exp2f(t.x); e.y = __builtin_amdgcn_exp2f(t.y);
                        const f32x2 d = e + 1.0f; f32x2 r; r.x = __builtin_amdgcn_rcpf(d.x); r.y = __builtin_amdgcn_rcpf(d.y);
                        const f32x2 hh = ((ag * au) * s2h) * r; h[n * 4 + j] = hh.x; h[n * 4 + j + 1] = hh.y; }
                if constexpr (F8OUT) { u32x2 w; w.x = pk4_fp8_ns(h[0], h[1], h[2], h[3]); w.y = pk4_fp8_ns(h[4], h[5], h[6], h[7]);
                    st_out(H, (unsigned char*)H + (size_t)row * ldh + col0, w); }
                else { u32x4 w; w.x = cvt_pk_bf16(h[0], h[1]); w.y = cvt_pk_bf16(h[2], h[3]); w.z = cvt_pk_bf16(h[4], h[5]); w.w = cvt_pk_bf16(h[6], h[7]);
                    st_out(H, H + (size_t)row * ldh + col0, w); } }
    }
};
struct EpiSwiGLUFold {
    static constexpr bool PERM = true; static constexpr unsigned WSCALE = 0x79797979u; static constexpr int A_AUX = 0, B_AUX = MOE1_B_AUX;
    unsigned char* H; int ldh; int ntmod;
    __device__ __forceinline__ void operator()(const f32x4 (&acc)[2][2][4][2], const Unit& u, int wr, int wc, int fr, int fq) const {
        const int row0 = u.pm * BM + wr * 64 + fr, col0 = (u.pn % ntmod) * HALF + wc * 32 + 8 * fq;
        typedef float f32x2 __attribute__((ext_vector_type(2)));
#pragma unroll
        for (int ai = 0; ai < 2; ++ai)
#pragma unroll
            for (int m = 0; m < 4; ++m) { const int row = row0 + ai * HALF + m * 16; float h[8];
#pragma unroll
                for (int n = 0; n < 2; ++n)
#pragma unroll
                    for (int j = 0; j < 4; j += 2) { const f32x2 ag = {acc[ai][0][m][n][j], acc[ai][0][m][n][j + 1]}, au = {acc[ai][1][m][n][j], acc[ai][1][m][n][j + 1]};
                        f32x2 e; e.x = __builtin_amdgcn_exp2f(-ag.x); e.y = __builtin_amdgcn_exp2f(-ag.y);
                        const f32x2 d = e + 1.0f; f32x2 r; r.x = __builtin_amdgcn_rcpf(d.x); r.y = __builtin_amdgcn_rcpf(d.y);
                        const f32x2 hh = (ag * au) * r; h[n * 4 + j] = hh.x; h[n * 4 + j + 1] = hh.y; }
                u32x2 w; w.x = pk4_fp8_ns(h[0], h[1], h[2], h[3]); w.y = pk4_fp8_ns(h[4], h[5], h[6], h[7]);
                st_out(H, H + (size_t)row * ldh + col0, w); }
    }
};
template <unsigned WS_ = 0x7F7F7F7Fu> struct EpiInProj1T {
    static constexpr bool PERM = true; static constexpr unsigned WSCALE = WS_; static constexpr int A_AUX = 0, B_AUX = 0;
    bf16_t* Z; int ldc; RowScaleT<16> R; float* SSKV; float* SSQ;
    __device__ __forceinline__ void operator()(const f32x4 (&acc)[2][2][4][2], const Unit& u, int wr, int wc, int fr, int fq) const {
        const int row0 = u.pm * BM + wr * 64 + fr, col0 = u.pn * BM + wc * 32 + 8 * fq;
        float sc[2][4];
#pragma unroll
        for (int ai = 0; ai < 2; ++ai)
#pragma unroll
            for (int m = 0; m < 4; ++m) sc[ai][m] = R.get(row0 + ai * HALF + m * 16, fq, fr);
#pragma unroll
        for (int ai = 0; ai < 2; ++ai)
#pragma unroll
            for (int m = 0; m < 4; ++m) { const int row = row0 + ai * HALF + m * 16; const float s = sc[ai][m]; bf16_t* rowp = Z + (size_t)row * ldc + col0; float q0 = 0.f, q1 = 0.f;
#pragma unroll
                for (int bj = 0; bj < 2; ++bj) { const f32x4 v0 = acc[ai][bj][m][0] * s, v1 = acc[ai][bj][m][1] * s;
                    u32x4 w; w.x = cvt_pk_bf16(v0[0], v0[1]); w.y = cvt_pk_bf16(v0[2], v0[3]); w.z = cvt_pk_bf16(v1[0], v1[1]); w.w = cvt_pk_bf16(v1[2], v1[3]);
                    st_out(Z, rowp + bj * HALF, w);
                    const float qq = (v0[0] * v0[0] + v0[1] * v0[1]) + (v0[2] * v0[2] + v0[3] * v0[3]) + (v1[0] * v1[0] + v1[1] * v1[1]) + (v1[2] * v1[2] + v1[3] * v1[3]);
                    if (bj == 0) q0 = qq; else q1 = qq; }
                if (u.pn <= 2) {
                    float q = (u.pn == 2) ? q0 : q0 + q1;
                    q = add_x16(q); q = add_x32(q);
                    if (fq == 0) { if (u.pn == 0) SSKV[(size_t)row * 4 + wc] = q; else SSQ[(size_t)row * 8 + (u.pn - 1) * 4 + wc] = q; } } }
    }
};
typedef EpiInProj1T<> EpiInProj1;
}
#define LAS __attribute__((address_space(3)))
#define GAS __attribute__((address_space(1)))
typedef unsigned short bf16;
typedef short bf16x8 __attribute__((ext_vector_type(8)));
typedef short s16x4 __attribute__((ext_vector_type(4)));
typedef float f32x16 __attribute__((ext_vector_type(16)));
typedef float f32x4 __attribute__((ext_vector_type(4)));
typedef float f32x2 __attribute__((ext_vector_type(2)));
typedef unsigned u32x4 __attribute__((ext_vector_type(4)));
typedef unsigned u32x2 __attribute__((ext_vector_type(2)));
#define SBAR() __builtin_amdgcn_sched_barrier(0)
__device__ __forceinline__ unsigned cvtpk(float lo, float hi) { return pg8::cvt_pk_bf16(lo, hi); }
__device__ __forceinline__ float bf_lo(unsigned w) { return __uint_as_float(w << 16); }
__device__ __forceinline__ float bf_hi(unsigned w) { return __uint_as_float(w & 0xffff0000u); }
__device__ __forceinline__ int crow(int r, int hi) { return (r & 3) + 8 * (r >> 2) + 4 * hi; }
__device__ __forceinline__ float swap_max(float v) { auto rr = __builtin_amdgcn_permlane32_swap(__float_as_uint(v), __float_as_uint(v), false, false); return fmaxf(__uint_as_float(rr[0]), __uint_as_float(rr[1])); }
__device__ __forceinline__ float swap_add(float v) { auto rr = __builtin_amdgcn_permlane32_swap(__float_as_uint(v), __float_as_uint(v), false, false); return __uint_as_float(rr[0]) + __uint_as_float(rr[1]); }
#define PK4(P, B_, OUT) do { unsigned a0 = cvtpk(P[B_+0], P[B_+1]), a1 = cvtpk(P[B_+2], P[B_+3]);                          \
        unsigned b0 = cvtpk(P[B_+4], P[B_+5]), b1 = cvtpk(P[B_+6], P[B_+7]);                                             \
        auto r0 = __builtin_amdgcn_permlane32_swap(a0, b0, false, false); auto r1 = __builtin_amdgcn_permlane32_swap(a1, b1, false, false); \
        u32x4 w = {r0[0], r1[0], r0[1], r1[1]}; OUT = *reinterpret_cast<bf16x8*>(&w); } while (0)
template <int NCB> __device__ __forceinline__ int v_st(int k, int c) { const int kk = (k & ~0xC) | ((k & 4) << 1) | ((k & 8) >> 1); return ((kk >> 3) * NCB + (c >> 5)) * 512 + ((kk & 7) * 32 + (c & 31)) * 2; }
__device__ __forceinline__ int v_rd_base(int lane) { return ((lane & 3) << 3) | (((lane >> 2) & 3) << 6) | (((lane >> 4) & 1) << 5) | (((lane >> 5) & 1) << 8); }
#define TRRD(dst, addr, off) asm volatile("ds_read_b64_tr_b16 %0, %1 offset:%2" : "=&v"(dst) : "v"(addr), "i"(off) : "memory")

#ifndef ATT_PRIO
#define ATT_PRIO 0
#endif
#ifndef ATT_WSKIP
#define ATT_WSKIP 1
#endif
template <int DQ, int DV> struct AttGeo {
    static constexpr int KROWB = DQ * 2 + 16, KBYTES = 64 * KROWB, NCB = DV / 32, VBYTES = 64 * DV * 2, V0 = 2 * KBYTES, TOTAL = 2 * KBYTES + 2 * VBYTES;
};
template <int DQ, int DV, bool CAUSAL, bool KNORM, bool ROPE, bool F8O = false>
__device__ __forceinline__ void attn_unit(int tid, LAS unsigned char* lds, const bf16* Qp, int ldq, const bf16* Kp, int ldk, const bf16* Vp, int ldv, bf16* Op, int ldo,
                                          int NT, int q0, const float* qg, const float* kg, float qscale, const f32x2* rope) {
    typedef AttGeo<DQ, DV> G;
    asm volatile("" : "+v"(tid));
    constexpr int NQ = DQ / 16, NDB = DV / 32, NCB = G::NCB, KCH = DQ / 8, VCH = DV / 8, NKP = 64 * KCH / 512, NVP = 64 * VCH / 512;
    static_assert(NKP * 512 == 64 * KCH && NVP * 512 == 64 * VCH, "staging geometry");
    const int wid = __builtin_amdgcn_readfirstlane(tid >> 6), lane = tid & 63, r32 = lane & 31, hi = lane >> 5;
    bf16x8 qr[NQ];
    { const bf16* qrow = Qp + (size_t)(wid * 32 + r32) * ldq + hi * 8;
      float ss = 0.f;
#pragma unroll
      for (int d0 = 0; d0 < NQ; ++d0) { qr[d0] = *(const bf16x8*)(qrow + d0 * 16); const u32x4 w = *reinterpret_cast<const u32x4*>(&qr[d0]);
#pragma unroll
          for (int j = 0; j < 4; ++j) { const float a = bf_lo(w[j]), b = bf_hi(w[j]); ss += a * a + b * b; } }
      ss = swap_add(ss);
      const float rq = qscale / sqrtf(ss * (1.0f / DQ) + 1e-6f);
      constexpr int NPLAIN = ROPE ? NQ - 4 : NQ;
#pragma unroll
      for (int d0 = 0; d0 < NPLAIN; ++d0) { const u32x4 w = *reinterpret_cast<const u32x4*>(&qr[d0]); const f32x4 g0 = *(const f32x4*)(qg + d0 * 16 + hi * 8), g1 = *(const f32x4*)(qg + d0 * 16 + hi * 8 + 4);
          u32x4 o; o.x = cvtpk(bf_lo(w.x) * rq * g0[0], bf_hi(w.x) * rq * g0[1]); o.y = cvtpk(bf_lo(w.y) * rq * g0[2], bf_hi(w.y) * rq * g0[3]);
          o.z = cvtpk(bf_lo(w.z) * rq * g1[0], bf_hi(w.z) * rq * g1[1]); o.w = cvtpk(bf_lo(w.w) * rq * g1[2], bf_hi(w.w) * rq * g1[3]); qr[d0] = *reinterpret_cast<bf16x8*>(&o); }
      if constexpr (ROPE) {
#pragma unroll
          for (int pp = 0; pp < 2; ++pp) { const int da = NQ - 4 + pp, db = NQ - 2 + pp;
              const u32x4 wa = *reinterpret_cast<const u32x4*>(&qr[da]), wb = *reinterpret_cast<const u32x4*>(&qr[db]);
              float xa[8], xb[8];
#pragma unroll
              for (int j = 0; j < 4; ++j) { xa[2 * j] = bf_lo(wa[j]); xa[2 * j + 1] = bf_hi(wa[j]); xb[2 * j] = bf_lo(wb[j]); xb[2 * j + 1] = bf_hi(wb[j]); }
              const float* ga = qg + da * 16 + hi * 8; const float* gb = qg + db * 16 + hi * 8;
              const f32x2* rp = rope + (size_t)(wid * 32 + r32) * 32 + pp * 16 + hi * 8;
              float ya[8], yb[8];
#pragma unroll
              for (int j = 0; j < 8; ++j) { const float x1 = xa[j] * rq * ga[j], x2 = xb[j] * rq * gb[j]; const f32x2 cs = rp[j]; ya[j] = x1 * cs.x - x2 * cs.y; yb[j] = x2 * cs.x + x1 * cs.y; }
              u32x4 oa, ob;
#pragma unroll
              for (int j = 0; j < 4; ++j) { oa[j] = cvtpk(ya[2 * j], ya[2 * j + 1]); ob[j] = cvtpk(yb[2 * j], yb[2 * j + 1]); }
              qr[da] = *reinterpret_cast<bf16x8*>(&oa); qr[db] = *reinterpret_cast<bf16x8*>(&ob); }
      }
    }
    bf16x8 kst[NKP], vst[NVP];
#define ATT_LOADT(j_) do { _Pragma("unroll") for (int i_ = 0; i_ < NKP; ++i_) { const int p_ = tid + 512 * i_, row_ = p_ / KCH, ch_ = p_ % KCH; kst[i_] = *(const bf16x8*)(Kp + (size_t)((j_) * 64 + row_) * ldk + ch_ * 8); } \
        _Pragma("unroll") for (int i_ = 0; i_ < NVP; ++i_) { const int p_ = tid + 512 * i_, row_ = p_ / VCH, ch_ = p_ % VCH; vst[i_] = *(const bf16x8*)(Vp + (size_t)((j_) * 64 + row_) * ldv + ch_ * 8); } } while (0)
#define ATT_WRITET(buf_) do { _Pragma("unroll") for (int i_ = 0; i_ < NKP; ++i_) { const int p_ = tid + 512 * i_, row_ = p_ / KCH, ch_ = p_ % KCH; bf16x8 kv_ = kst[i_]; \
            if constexpr (KNORM) { const u32x4 w_ = *reinterpret_cast<const u32x4*>(&kv_); float f_[8]; float s_ = 0.f; \
                _Pragma("unroll") for (int j_ = 0; j_ < 4; ++j_) { f_[2 * j_] = bf_lo(w_[j_]); f_[2 * j_ + 1] = bf_hi(w_[j_]); s_ += f_[2 * j_] * f_[2 * j_] + f_[2 * j_ + 1] * f_[2 * j_ + 1]; } \
                s_ += __shfl_xor(s_, 1); s_ += __shfl_xor(s_, 2); s_ += __shfl_xor(s_, 4); const float rk_ = 1.0f / sqrtf(s_ * (1.0f / DQ) + 1e-6f); \
                const f32x4 g0_ = *(const f32x4*)(kg + ch_ * 8), g1_ = *(const f32x4*)(kg + ch_ * 8 + 4); u32x4 o_; \
                o_.x = cvtpk(f_[0] * rk_ * g0_[0], f_[1] * rk_ * g0_[1]); o_.y = cvtpk(f_[2] * rk_ * g0_[2], f_[3] * rk_ * g0_[3]); o_.z = cvtpk(f_[4] * rk_ * g1_[0], f_[5] * rk_ * g1_[1]); o_.w = cvtpk(f_[6] * rk_ * g1_[2], f_[7] * rk_ * g1_[3]); \
                kv_ = *reinterpret_cast<bf16x8*>(&o_); } \
            *(LAS bf16x8*)(lds + (buf_) * G::KBYTES + row_ * G::KROWB + ch_ * 16) = kv_; } \
        _Pragma("unroll") for (int i_ = 0; i_ < NVP; ++i_) { const int p_ = tid + 512 * i_, row_ = p_ / VCH, ch_ = p_ % VCH; *(LAS bf16x8*)(lds + G::V0 + (buf_) * G::VBYTES + v_st<NCB>(row_, ch_ * 8)) = vst[i_]; } } while (0)
    static_assert(!KNORM || KCH == 8, "KNORM reduces over 8 consecutive lanes");
    ATT_LOADT(0); ATT_WRITET(0); if (NT > 1) ATT_LOADT(1);
    __syncthreads();
    float m_reg = -1e30f, l_reg = 0.f; f32x16 o[NDB];
#pragma unroll
    for (int d = 0; d < NDB; ++d) o[d] = f32x16{};
    const unsigned vb0 = (unsigned)(uintptr_t)(lds + G::V0) + (unsigned)v_rd_base(lane);
    const int qfirst = q0 + wid * 32, qrow = qfirst + r32;
    for (int j = 0; j < NT; ++j) {
        const int buf = j & 1;
        if (j + 1 < NT) { ATT_WRITET(buf ^ 1); if (j + 2 < NT) ATT_LOADT(j + 2); }
        const bool act = !ATT_WSKIP || !CAUSAL || (64 * j <= qfirst + 31);
        if (act) {
            f32x16 p0 = f32x16{}, p1 = f32x16{};
            const LAS unsigned char* kb = lds + buf * G::KBYTES + r32 * G::KROWB + hi * 16;
#pragma unroll
            for (int d0 = 0; d0 < NQ; ++d0) { const bf16x8 a0 = *(const LAS bf16x8*)(kb + d0 * 32), a1 = *(const LAS bf16x8*)(kb + 32 * G::KROWB + d0 * 32);
                p0 = __builtin_amdgcn_mfma_f32_32x32x16_bf16(a0, qr[d0], p0, 0, 0, 0); p1 = __builtin_amdgcn_mfma_f32_32x32x16_bf16(a1, qr[d0], p1, 0, 0, 0); }
            if (CAUSAL && (64 * j + 63 > qfirst)) { const float NEG = -__builtin_inff(); const int dq = qrow - 64 * j - 4 * hi;
#pragma unroll
                for (int r = 0; r < 16; ++r) { const int c = (r & 3) + 8 * (r >> 2); if (c > dq) p0[r] = NEG; if (c + 32 > dq) p1[r] = NEG; } }
            float pmax = p0[0];
#pragma unroll
            for (int r = 1; r < 16; ++r) pmax = fmaxf(pmax, p0[r]);
#pragma unroll
            for (int r = 0; r < 16; ++r) pmax = fmaxf(pmax, p1[r]);
            pmax = swap_max(pmax);
            float mn, alpha;
            if (__all(pmax - m_reg <= 11.5f)) { mn = m_reg; alpha = 1.f; }
            else { mn = fmaxf(m_reg, pmax); alpha = __builtin_amdgcn_exp2f(m_reg - mn); m_reg = mn; }
            float ps = 0.f;
#pragma unroll
            for (int r = 0; r < 16; ++r) { p0[r] = __builtin_amdgcn_exp2f(p0[r] - mn); p1[r] = __builtin_amdgcn_exp2f(p1[r] - mn); ps += p0[r] + p1[r]; }
            ps = swap_add(ps);
            l_reg = l_reg * alpha + ps;
            if (__any(alpha < 1.f)) {
#pragma unroll
                for (int d = 0; d < NDB; ++d)
#pragma unroll
                    for (int r = 0; r < 16; ++r) o[d][r] *= alpha; }
            bf16x8 pa0, pa1, pa2, pa3;
            PK4(p0, 0, pa0); PK4(p0, 8, pa1); PK4(p1, 0, pa2); PK4(p1, 8, pa3);
            const unsigned vb = vb0 + (unsigned)(buf * G::VBYTES);
#pragma unroll
            for (int d0 = 0; d0 < NDB; ++d0) { s16x4 l0, l1, l2, l3, h0, h1, h2, h3;
                TRRD(l0, vb, d0 * 512 + 0 * NCB * 1024); TRRD(h0, vb, d0 * 512 + 0 * NCB * 1024 + NCB * 512);
                TRRD(l1, vb, d0 * 512 + 1 * NCB * 1024); TRRD(h1, vb, d0 * 512 + 1 * NCB * 1024 + NCB * 512);
                TRRD(l2, vb, d0 * 512 + 2 * NCB * 1024); TRRD(h2, vb, d0 * 512 + 2 * NCB * 1024 + NCB * 512);
                TRRD(l3, vb, d0 * 512 + 3 * NCB * 1024); TRRD(h3, vb, d0 * 512 + 3 * NCB * 1024 + NCB * 512);
                asm volatile("s_waitcnt lgkmcnt(0)" ::: "memory"); SBAR();
                o[d0] = __builtin_amdgcn_mfma_f32_32x32x16_bf16((bf16x8){l0[0], l0[1], l0[2], l0[3], h0[0], h0[1], h0[2], h0[3]}, pa0, o[d0], 0, 0, 0);
                o[d0] = __builtin_amdgcn_mfma_f32_32x32x16_bf16((bf16x8){l1[0], l1[1], l1[2], l1[3], h1[0], h1[1], h1[2], h1[3]}, pa1, o[d0], 0, 0, 0);
                o[d0] = __builtin_amdgcn_mfma_f32_32x32x16_bf16((bf16x8){l2[0], l2[1], l2[2], l2[3], h2[0], h2[1], h2[2], h2[3]}, pa2, o[d0], 0, 0, 0);
                o[d0] = __builtin_amdgcn_mfma_f32_32x32x16_bf16((bf16x8){l3[0], l3[1], l3[2], l3[3], h3[0], h3[1], h3[2], h3[3]}, pa3, o[d0], 0, 0, 0); }
        }
        asm volatile("s_waitcnt lgkmcnt(0)" ::: "memory"); __builtin_amdgcn_s_barrier(); asm volatile("" ::: "memory");
    }
#undef ATT_LOADT
#undef ATT_WRITET
    const float rl = 1.0f / l_reg;
    if constexpr (F8O) { unsigned char* orow8 = (unsigned char*)Op + (size_t)(wid * 32 + r32) * ldo + 4 * hi;
#pragma unroll
        for (int d0 = 0; d0 < NDB; ++d0)
#pragma unroll
            for (int g4 = 0; g4 < 4; ++g4) *(unsigned*)(orow8 + d0 * 32 + 8 * g4) = pg8::pk4_fp8(o[d0][4 * g4] * rl, o[d0][4 * g4 + 1] * rl, o[d0][4 * g4 + 2] * rl, o[d0][4 * g4 + 3] * rl); }
    else {
    bf16* orow = Op + (size_t)(wid * 32 + r32) * ldo + 4 * hi;
#pragma unroll
    for (int d0 = 0; d0 < NDB; ++d0)
#pragma unroll
        for (int g4 = 0; g4 < 4; ++g4) { u32x2 w; w.x = cvtpk(o[d0][4 * g4] * rl, o[d0][4 * g4 + 1] * rl); w.y = cvtpk(o[d0][4 * g4 + 2] * rl, o[d0][4 * g4 + 3] * rl);
            *(u32x2*)(orow + d0 * 32 + 8 * g4) = w; } }
    __syncthreads();
}
#ifndef ML_SCAN8
#define ML_SCAN8 0
#endif
#ifndef ML_GATE_WAVE
#define ML_GATE_WAVE 1
#endif
#ifndef ML_WIDE_ST
#define ML_WIDE_ST 1
#endif
#ifndef ML_TFAST
#define ML_TFAST 1
#endif
constexpr int ML_H = 4, ML_DK = 96, ML_DV = 192, ML_L = 64, ML_NC = 32, ML_CROWS = 224;
constexpr int ML_P0LD = 2560, ML_QOFF = 0, ML_KOFF = 384, ML_VOFF = 768, ML_OOFF = 1536;
constexpr int ML_TROW = 144;
__device__ __forceinline__ float wave_incl_sum(float v, int) {
    v += __builtin_bit_cast(float, __builtin_amdgcn_update_dpp(0, __builtin_bit_cast(int, v), 0x111, 0xF, 0xF, true));
    v += __builtin_bit_cast(float, __builtin_amdgcn_update_dpp(0, __builtin_bit_cast(int, v), 0x112, 0xF, 0xF, true));
    v += __builtin_bit_cast(float, __builtin_amdgcn_update_dpp(0, __builtin_bit_cast(int, v), 0x114, 0xF, 0xF, true));
    v += __builtin_bit_cast(float, __builtin_amdgcn_update_dpp(0, __builtin_bit_cast(int, v), 0x118, 0xF, 0xF, true));
    v += __builtin_bit_cast(float, __builtin_amdgcn_update_dpp(0, __builtin_bit_cast(int, v), 0x142, 0xA, 0xF, false));
    v += __builtin_bit_cast(float, __builtin_amdgcn_update_dpp(0, __builtin_bit_cast(int, v), 0x143, 0xC, 0xF, false));
    return v;
}
__device__ __forceinline__ float wave_incl_max(float v, int) {
    const int NI = (int)0xff800000u;
    v = fmaxf(v, __builtin_bit_cast(float, __builtin_amdgcn_update_dpp(NI, __builtin_bit_cast(int, v), 0x111, 0xF, 0xF, false)));
    v = fmaxf(v, __builtin_bit_cast(float, __builtin_amdgcn_update_dpp(NI, __builtin_bit_cast(int, v), 0x112, 0xF, 0xF, false)));
    v = fmaxf(v, __builtin_bit_cast(float, __builtin_amdgcn_update_dpp(NI, __builtin_bit_cast(int, v), 0x114, 0xF, 0xF, false)));
    v = fmaxf(v, __builtin_bit_cast(float, __builtin_amdgcn_update_dpp(NI, __builtin_bit_cast(int, v), 0x118, 0xF, 0xF, false)));
    v = fmaxf(v, __builtin_bit_cast(float, __builtin_amdgcn_update_dpp(NI, __builtin_bit_cast(int, v), 0x142, 0xA, 0xF, false)));
    v = fmaxf(v, __builtin_bit_cast(float, __builtin_amdgcn_update_dpp(NI, __builtin_bit_cast(int, v), 0x143, 0xC, 0xF, false)));
    return v;
}
__device__ __forceinline__ float wave_max(float v) {
#pragma unroll
    for (int o = 1; o < 64; o <<= 1) v = fmaxf(v, __shfl_xor(v, o));
    return v;
}
__device__ __forceinline__ float wave_sum(float v) {
    v += __builtin_bit_cast(float, __builtin_amdgcn_update_dpp(0, __builtin_bit_cast(int, v), 0xB1, 0xF, 0xF, true));
    v += __builtin_bit_cast(float, __builtin_amdgcn_update_dpp(0, __builtin_bit_cast(int, v), 0x4E, 0xF, 0xF, true));
    v += __builtin_bit_cast(float, __builtin_amdgcn_update_dpp(0, __builtin_bit_cast(int, v), 0x141, 0xF, 0xF, true));
    v += __builtin_bit_cast(float, __builtin_amdgcn_update_dpp(0, __builtin_bit_cast(int, v), 0x140, 0xF, 0xF, true));
    { auto rr = __builtin_amdgcn_permlane16_swap(__float_as_uint(v), __float_as_uint(v), false, false); v = __uint_as_float(rr[0]) + __uint_as_float(rr[1]); }
    { auto rr = __builtin_amdgcn_permlane32_swap(__float_as_uint(v), __float_as_uint(v), false, false); v = __uint_as_float(rr[0]) + __uint_as_float(rr[1]); }
    return v;
}
__device__ __forceinline__ float log_sigmoid(float x) { return fminf(x, 0.f) - log1pf(expf(-fabsf(x))); }
__device__ __forceinline__ void tr_store8(LAS unsigned char* base, int col, int t, const u32x4 w) {
#pragma unroll
    for (int j = 0; j < 4; ++j) { *(LAS unsigned short*)(base + (col + 2 * j) * ML_TROW + t * 2) = (unsigned short)(w[j] & 0xffffu); *(LAS unsigned short*)(base + (col + 2 * j + 1) * ML_TROW + t * 2) = (unsigned short)(w[j] >> 16); }
}
__device__ __forceinline__ void mlstm_a_wg(int tid, LAS unsigned char* lds, int first, int stride, int nchunks, const bf16* PROJ0, const float* IFG, bf16* CLOC, float* GLML) {
    asm volatile("" : "+v"(tid));
    const int wid = __builtin_amdgcn_readfirstlane(tid >> 6), lane = tid & 63, r32 = lane & 31, hi = lane >> 5;
    LAS unsigned char* vT = lds; LAS unsigned char* kT = lds + 32768; LAS float* el = (LAS float*)(lds + 49152);
    if (first >= nchunks) return;
    for (int p = tid; p < 32 * 64; p += 512) { const int r = 192 + (p >> 6), t = p & 63; *(LAS unsigned short*)(vT + r * ML_TROW + t * 2) = (r == 192) ? (unsigned short)0x3F80u : (unsigned short)0u; }
    u32x4 kq[2], vq[3]; float ig = 0.f, fp = 0.f;
#if ML_TFAST
    const int kt[2] = {tid % 64, (tid + 512) % 64}, kc_[2] = {tid / 64, (tid + 512) / 64};
    const int vt[3] = {tid % 64, (tid + 512) % 64, (tid + 1024) % 64}, vc[3] = {tid / 64, (tid + 512) / 64, (tid + 1024) / 64};
#else
    const int kt[2] = {tid / 12, (tid + 512) / 12}, kc_[2] = {tid % 12, (tid + 512) % 12};
    const int vt[3] = {tid / 24, (tid + 512) / 24, (tid + 1024) / 24}, vc[3] = {tid % 24, (tid + 512) % 24, (tid + 1024) % 24};
#endif
#define MLA_LOAD(cid_) do { const int bh_ = (cid_) >> 5, c_ = (cid_) & 31, h_ = bh_ & 3, tok0_ = (bh_ >> 2) * 2048 + c_ * 64; \
        kq[0] = *(const u32x4*)(PROJ0 + (size_t)(tok0_ + kt[0]) * ML_P0LD + ML_KOFF + h_ * ML_DK + kc_[0] * 8); \
        if (tid < 256) kq[1] = *(const u32x4*)(PROJ0 + (size_t)(tok0_ + kt[1]) * ML_P0LD + ML_KOFF + h_ * ML_DK + kc_[1] * 8); \
        _Pragma("unroll") for (int i_ = 0; i_ < 3; ++i_) vq[i_] = *(const u32x4*)(PROJ0 + (size_t)(tok0_ + vt[i_]) * ML_P0LD + ML_VOFF + h_ * ML_DV + vc[i_] * 8); \
        if (wid == 0) { ig = IFG[(size_t)(tok0_ + lane) * 8 + h_]; fp = IFG[(size_t)(tok0_ + lane) * 8 + 4 + h_]; } } while (0)
#define MLA_LBAR() do { asm volatile("s_waitcnt lgkmcnt(0)" ::: "memory"); __builtin_amdgcn_s_barrier(); asm volatile("" ::: "memory"); } while (0)
#define MLA_GATES(cid_, elb_) do { const float g = wave_incl_sum(log_sigmoid(fp), lane), gl = __shfl(g, 63); \
            const float w = gl - g + ig, ml = wave_max(w); \
            (elb_)[lane] = expf(w - ml) * 0.10206207261596575f;                   \
            if (lane == 0) { GLML[(cid_) * 2] = gl; GLML[(cid_) * 2 + 1] = ml; } } while (0)
    MLA_LOAD(first);
#if ML_GATE_WAVE
    if (wid == 0) MLA_GATES(first, el);
    int eb_ = 0;
#endif
    for (int cid = first; cid < nchunks; cid += stride) {
#if ML_GATE_WAVE
        LAS float* elc = el + 64 * eb_; eb_ ^= 1;
#else
        LAS float* elc = el;
        if (wid == 0) MLA_GATES(cid, el);
#endif
        MLA_LBAR();
#pragma unroll
        for (int i = 0; i < 2; ++i) if (i == 0 || tid < 256) { const float e = elc[kt[i]]; u32x4 o;
#pragma unroll
            for (int j = 0; j < 4; ++j) o[j] = cvtpk(bf_lo(kq[i][j]) * e, bf_hi(kq[i][j]) * e);
            tr_store8(kT, kc_[i] * 8, kt[i], o); }
#pragma unroll
        for (int i = 0; i < 3; ++i) tr_store8(vT, vc[i] * 8, vt[i], vq[i]);
        if (cid + stride < nchunks) MLA_LOAD(cid + stride);
        MLA_LBAR();
        bf16* Cout = CLOC + (size_t)cid * ML_CROWS * ML_DK;
#if ML_GATE_WAVE
        if (wid == 0) { if (cid + stride < nchunks) MLA_GATES(cid + stride, el + 64 * eb_); }
        else
        for (int tile = wid - 1; tile < 21; tile += 7) { const int db = tile / 3, eb = tile % 3;
#else
        for (int tile = wid; tile < 21; tile += 8) { const int db = tile / 3, eb = tile % 3;
#endif
            f32x16 acc = f32x16{};
#pragma unroll
            for (int ks = 0; ks < 4; ++ks) { const bf16x8 a = *(const LAS bf16x8*)(vT + (db * 32 + r32) * ML_TROW + (ks * 16 + hi * 8) * 2), bb = *(const LAS bf16x8*)(kT + (eb * 32 + r32) * ML_TROW + (ks * 16 + hi * 8) * 2);
                acc = __builtin_amdgcn_mfma_f32_32x32x16_bf16(a, bb, acc, 0, 0, 0); }
#if ML_WIDE_ST
            { LAS unsigned char* wsc = lds + 53248 + wid * 2560;
#pragma unroll
              for (int r = 0; r < 16; ++r) *(LAS unsigned short*)(wsc + crow(r, hi) * 80 + r32 * 2) = (unsigned short)(cvtpk(acc[r], 0.f) & 0xffffu);
              const int row = lane >> 1, half = lane & 1;
              const u32x4 w0 = *(const LAS u32x4*)(wsc + row * 80 + half * 32), w1 = *(const LAS u32x4*)(wsc + row * 80 + half * 32 + 16);
              bf16* op = Cout + (size_t)(db * 32 + row) * ML_DK + eb * 32 + half * 16;
              *(u32x4*)op = w0; *(u32x4*)(op + 8) = w1; } }
#else
#pragma unroll
            for (int r = 0; r < 16; ++r) { const int d = db * 32 + crow(r, hi); Cout[(size_t)d * ML_DK + eb * 32 + r32] = (bf16)(cvtpk(acc[r], 0.f) & 0xffffu); } }
#endif
#if !ML_GATE_WAVE
        MLA_LBAR();
#endif
    }
#if ML_GATE_WAVE
    MLA_LBAR();
#endif
#undef MLA_GATES
#undef MLA_LOAD
#undef MLA_LBAR
}
__device__ __forceinline__ void mlstm_b_item(int tid, int wi, const bf16* CLOC, bf16* CPREV, const float* GLML, float* MPREV) {
    asm volatile("" : "+v"(tid));
#if ML_SCAN8
    const int bh = wi >> 3, part = wi & 7, grp = part * 290 + tid; const bool on = tid < 290 && grp < 2316;
#else
    const int bh = wi / 5, part = wi % 5, grp = part * 512 + tid; const bool on = grp < 2316;
#endif
    float C8[8];
#pragma unroll
    for (int j = 0; j < 8; ++j) C8[j] = 0.f;
    const size_t cstride = (size_t)ML_CROWS * ML_DK;
    const bf16* src = CLOC + (size_t)bh * 32 * cstride + (size_t)grp * 8; bf16* dst = CPREV + (size_t)bh * 32 * cstride + (size_t)grp * 8;
    float ca = 0.f, cb = 0.f, cm = 0.f;
    { const int lc = tid & 31; const float glv = GLML[(bh * 32 + lc) * 2], mlv = GLML[(bh * 32 + lc) * 2 + 1]; float m = 0.f;
#pragma unroll
      for (int c = 0; c < ML_NC; ++c) { const float gl = __uint_as_float(__builtin_amdgcn_readlane(__float_as_uint(glv), c)), ml = __uint_as_float(__builtin_amdgcn_readlane(__float_as_uint(mlv), c));
          const float mn = fmaxf(gl + m, ml), a = expf(gl + m - mn), bb = expf(ml - mn);
          if (lc == c) { ca = a; cb = bb; cm = m; }
          m = mn; }
      if (part == 0 && tid < 32) MPREV[bh * 32 + tid] = cm; }
#pragma unroll
    for (int c0 = 0; c0 < ML_NC; c0 += 16) {
        u32x4 cl[16];
#pragma unroll
        for (int i = 0; i < 16; ++i) cl[i] = on ? __builtin_nontemporal_load((const u32x4*)(src + (size_t)(c0 + i) * cstride)) : (u32x4){0u, 0u, 0u, 0u};
#pragma unroll
        for (int i = 0; i < 16; ++i) { const int c = c0 + i;
            if (on) { u32x4 o; o.x = cvtpk(C8[0], C8[1]); o.y = cvtpk(C8[2], C8[3]); o.z = cvtpk(C8[4], C8[5]); o.w = cvtpk(C8[6], C8[7]); *(u32x4*)(dst + (size_t)c * cstride) = o; }
            const float a = __uint_as_float(__builtin_amdgcn_readlane(__float_as_uint(ca), c)), bb = __uint_as_float(__builtin_amdgcn_readlane(__float_as_uint(cb), c));
#pragma unroll
            for (int j = 0; j < 4; ++j) { C8[2 * j] = a * C8[2 * j] + bb * bf_lo(cl[i][j]); C8[2 * j + 1] = a * C8[2 * j + 1] + bb * bf_hi(cl[i][j]); } }
    }
}
constexpr int ML_VTB = 200 * ML_TROW;
__device__ __forceinline__ void mlstm_c_group(int tid, LAS unsigned char* lds, int cid0, const bf16* PROJ0, const float* IFG, const bf16* CPREV, const float* MPREV, const float* head_g, bf16* MIX) {
    asm volatile("" : "+v"(tid));
    const int wid = __builtin_amdgcn_readfirstlane(tid >> 6), lane = tid & 63, r32 = lane & 31, hi = lane >> 5;
    const int cw = wid >> 1, rb = wid & 1, cid = cid0 + cw, bh = cid >> 5, c = cid & 31, b = bh >> 2, h = bh & 3, tok0 = b * 2048 + c * 64;
    const int tr = rb * 32 + r32;
    const float ig = IFG[(size_t)(tok0 + lane) * 8 + h], fp = IFG[(size_t)(tok0 + lane) * 8 + 4 + h], mprev = MPREV[cid];
    const bf16* qrow = PROJ0 + (size_t)(tok0 + tr) * ML_P0LD + ML_QOFF + h * ML_DK + hi * 8;
    bf16x8 qr[6], ka0[6], ka1[6];
    { const bf16* k0 = PROJ0 + (size_t)(tok0 + r32) * ML_P0LD + ML_KOFF + h * ML_DK + hi * 8; const bf16* k1 = k0 + (size_t)32 * ML_P0LD;
#pragma unroll
      for (int d0 = 0; d0 < 6; ++d0) { qr[d0] = *(const bf16x8*)(qrow + d0 * 16); ka0[d0] = *(const bf16x8*)(k0 + d0 * 16); ka1[d0] = *(const bf16x8*)(k1 + d0 * 16); } }
#pragma unroll
    for (int i = 0; i < 12; ++i) { const int p = tid + 512 * i, ck = p / 1536, rem = p % 1536, t = ML_TFAST ? rem % 64 : rem / 24, ch = ML_TFAST ? rem / 64 : rem % 24;
        const int cid_ = cid0 + ck, bh_ = cid_ >> 5, c_ = cid_ & 31, tok = (bh_ >> 2) * 2048 + c_ * 64 + t;
        const u32x4 w = *(const u32x4*)(PROJ0 + (size_t)tok * ML_P0LD + ML_VOFF + (bh_ & 3) * ML_DV + ch * 8);
        tr_store8(lds + ck * ML_VTB, ch * 8, t, w); }
    if (tid < 256) *(LAS unsigned short*)(lds + (tid >> 6) * ML_VTB + 192 * ML_TROW + (tid & 63) * 2) = (unsigned short)0x3F80u;
    __syncthreads();
    const LAS unsigned char* vT = lds + cw * ML_VTB;
    const bf16* Cp = CPREV + (size_t)cid * ML_CROWS * ML_DK + (size_t)r32 * ML_DK + hi * 8;
    bf16x8 cp6[6], cpb[3][6];
#pragma unroll
    for (int d0 = 0; d0 < 6; ++d0) { cp6[d0] = *(const bf16x8*)(Cp + (size_t)6 * 32 * ML_DK + d0 * 16); cpb[0][d0] = *(const bf16x8*)(Cp + d0 * 16); cpb[1][d0] = *(const bf16x8*)(Cp + (size_t)32 * ML_DK + d0 * 16); }
    const float g = wave_incl_sum(log_sigmoid(fp), lane), bq = ig - g, bmax = wave_incl_max(bq, lane);
    const float gT = __shfl(g, tr), bmT = __shfl(bmax, tr), mt = gT + fmaxf(mprev, bmT), inter = expf(gT + mprev - mt), gm = gT - mt;
    f32x16 p0 = f32x16{}, p1 = f32x16{};
#pragma unroll
    for (int d0 = 0; d0 < 6; ++d0) { p0 = __builtin_amdgcn_mfma_f32_32x32x16_bf16(ka0[d0], qr[d0], p0, 0, 0, 0); p1 = __builtin_amdgcn_mfma_f32_32x32x16_bf16(ka1[d0], qr[d0], p1, 0, 0, 0); }
    LAS float* bqt = (LAS float*)(lds + 4 * ML_VTB) + wid * 64;
    bqt[lane] = bq;
    asm volatile("s_waitcnt lgkmcnt(0)" ::: "memory");
    const LAS float* bqr = bqt + 4 * hi;
#pragma unroll
    for (int r = 0; r < 16; ++r) { const int s0 = crow(r, hi), s1 = s0 + 32; const float b0 = bqr[(r & 3) + 8 * (r >> 2)], b1 = bqr[32 + (r & 3) + 8 * (r >> 2)];
        p0[r] = (s0 <= tr) ? __builtin_amdgcn_exp2f((gm + b0) * 1.4426950408889634f) * p0[r] * 0.10206207261596575f : 0.f;
        p1[r] = (s1 <= tr) ? __builtin_amdgcn_exp2f((gm + b1) * 1.4426950408889634f) * p1[r] * 0.10206207261596575f : 0.f; }
    bf16x8 pa0, pa1, pa2, pa3;
    PK4(p0, 0, pa0); PK4(p0, 8, pa1); PK4(p1, 0, pa2); PK4(p1, 8, pa3);
#pragma unroll
    for (int d0 = 0; d0 < 6; ++d0) { const u32x4 w = *reinterpret_cast<const u32x4*>(&qr[d0]); u32x4 o_;
#pragma unroll
        for (int j = 0; j < 4; ++j) o_[j] = cvtpk(bf_lo(w[j]) * inter, bf_hi(w[j]) * inter);
        qr[d0] = *reinterpret_cast<bf16x8*>(&o_); }
    const bf16* orow = PROJ0 + (size_t)(tok0 + tr) * ML_P0LD + ML_OOFF + h * ML_DV + 4 * hi;
    u32x2 owp[6][4];
#pragma unroll
    for (int db = 0; db < 6; ++db)
#pragma unroll
        for (int g4 = 0; g4 < 4; ++g4) owp[db][g4] = *(const u32x2*)(orow + db * 32 + 8 * g4);
    float den;
    { f32x16 acc = f32x16{};
#pragma unroll
      for (int d0 = 0; d0 < 6; ++d0) acc = __builtin_amdgcn_mfma_f32_32x32x16_bf16(cp6[d0], qr[d0], acc, 0, 0, 0);
      const LAS unsigned char* vr = vT + (6 * 32 + r32) * ML_TROW + hi * 16;
      acc = __builtin_amdgcn_mfma_f32_32x32x16_bf16(*(const LAS bf16x8*)(vr), pa0, acc, 0, 0, 0);
      acc = __builtin_amdgcn_mfma_f32_32x32x16_bf16(*(const LAS bf16x8*)(vr + 32), pa1, acc, 0, 0, 0);
      acc = __builtin_amdgcn_mfma_f32_32x32x16_bf16(*(const LAS bf16x8*)(vr + 64), pa2, acc, 0, 0, 0);
      acc = __builtin_amdgcn_mfma_f32_32x32x16_bf16(*(const LAS bf16x8*)(vr + 96), pa3, acc, 0, 0, 0);
      den = __shfl(acc[0], r32); }
    f32x16 o[6];
#pragma unroll
    for (int db = 0; db < 6; ++db) { f32x16 acc = f32x16{};
        if (db + 2 < 6) {
#pragma unroll
            for (int d0 = 0; d0 < 6; ++d0) cpb[(db + 2) % 3][d0] = *(const bf16x8*)(Cp + (size_t)(db + 2) * 32 * ML_DK + d0 * 16); }
#pragma unroll
        for (int d0 = 0; d0 < 6; ++d0) acc = __builtin_amdgcn_mfma_f32_32x32x16_bf16(cpb[db % 3][d0], qr[d0], acc, 0, 0, 0);
        const LAS unsigned char* vr = vT + (db * 32 + r32) * ML_TROW + hi * 16;
        acc = __builtin_amdgcn_mfma_f32_32x32x16_bf16(*(const LAS bf16x8*)(vr), pa0, acc, 0, 0, 0);
        acc = __builtin_amdgcn_mfma_f32_32x32x16_bf16(*(const LAS bf16x8*)(vr + 32), pa1, acc, 0, 0, 0);
        acc = __builtin_amdgcn_mfma_f32_32x32x16_bf16(*(const LAS bf16x8*)(vr + 64), pa2, acc, 0, 0, 0);
        acc = __builtin_amdgcn_mfma_f32_32x32x16_bf16(*(const LAS bf16x8*)(vr + 96), pa3, acc, 0, 0, 0);
        o[db] = acc; }
    const float hs = 1.0f / fmaxf(fabsf(den), expf(-mt));
    float ssq = 0.f;
#pragma unroll
    for (int db = 0; db < 6; ++db)
#pragma unroll
        for (int r = 0; r < 16; ++r) { o[db][r] *= hs; ssq += o[db][r] * o[db][r]; }
    ssq = swap_add(ssq);
    const float rs = 1.0f / sqrtf(ssq * (1.0f / ML_DV) + 1e-6f);
    bf16* mrow = MIX + (size_t)(tok0 + tr) * 1024 + h * ML_DV + 4 * hi; const float* hg = head_g + h * ML_DV + 4 * hi;
#pragma unroll
    for (int db = 0; db < 6; ++db)
#pragma unroll
        for (int g4 = 0; g4 < 4; ++g4) { const int d = db * 32 + 8 * g4; const u32x2 ow = owp[db][g4]; const f32x4 gg = *(const f32x4*)(hg + d);
            const float o0 = bf_lo(ow.x), o1 = bf_hi(ow.x), o2 = bf_lo(ow.y), o3 = bf_hi(ow.y);
#define ML_SIG(x_) __builtin_amdgcn_rcpf(1.0f + __builtin_amdgcn_exp2f(-1.4426950408889634f * (x_)))
            const float y0 = o[db][4 * g4] * rs * gg[0] * ML_SIG(o0), y1 = o[db][4 * g4 + 1] * rs * gg[1] * ML_SIG(o1);
            const float y2 = o[db][4 * g4 + 2] * rs * gg[2] * ML_SIG(o2), y3 = o[db][4 * g4 + 3] * rs * gg[3] * ML_SIG(o3);
#undef ML_SIG
            u32x2 w; w.x = cvtpk(y0, y1); w.y = cvtpk(y2, y3); *(u32x2*)(mrow + d) = w; }
    __syncthreads();
}
#ifndef FFN2_FP8
#define FFN2_FP8 0
#endif
#ifndef MOE1_PEEL
#define MOE1_PEEL 0
#endif
#ifndef KFIN_FUSED
#define KFIN_FUSED 0
#endif
#ifndef YP_FP8
#define YP_FP8 0
#endif
#ifndef MEM0_IN_SCAN
#define MEM0_IN_SCAN 0
#endif
#ifndef L1_FP8
#define L1_FP8 0
#endif
constexpr int NWAVES = 8;
constexpr int T = 16384, D = 1024, SEQ = 2048, NB = 8, FF = 3584, NEXP = 8;
constexpr int NMEMROWS = 2048;
constexpr int SLOT_ROWS = 34816;
constexpr float EPS = 1e-6f;

constexpr size_t MiB = 1u << 20;
#ifndef P1_MEMQ
#define P1_MEMQ 0
#endif
constexpr size_t WS_CTL = 0, CTL_ZERO_BYTES = P1_MEMQ ? 131072 : 65536;
constexpr size_t WS_W_IN0 = 1 * MiB, WS_W_MEM = 6 * MiB, WS_W_OUT0 = 8 * MiB, WS_W_GU0 = 10 * MiB, WS_W_D0 = 24 * MiB, WS_W_IN1 = 31 * MiB, WS_W_UKV = 33 * MiB, WS_W_UQ = 34 * MiB,
                 WS_W_OUT1 = 35 * MiB, WS_W_GU1 = 37 * MiB, WS_W_D1 = 149 * MiB;
constexpr size_t WS_XB = 205 * MiB, WS_MIX = 237 * MiB, WS_XA = 269 * MiB, WS_XC = 333 * MiB, WS_MEMB = 397 * MiB, WS_MEMKV = 401 * MiB, WS_SM = 405 * MiB;
constexpr size_t WS_R0 = WS_SM, WS_RM = WS_SM + 65536, WS_IFG = WS_SM + 131072, WS_SS = WS_SM + 1 * MiB, WS_SSKV = WS_SM + 2 * MiB, WS_SSQ = WS_SM + 2 * MiB + 524288, WS_GLML = WS_SM + 3 * MiB,
                 WS_MPREV = WS_SM + 3 * MiB + 65536, WS_ROPE = WS_SM + 4 * MiB, WS_TOPK = WS_SM + 8 * MiB, WS_RS3 = WS_SM + 8 * MiB + 524288, WS_SLOT_TOK = WS_SM + 9 * MiB,
                 WS_SLOT_GATE = WS_SM + 9 * MiB + 262144, WS_SLOT_RS = WS_SM + 9 * MiB + 524288, WS_TOK_SLOT = WS_SM + 9 * MiB + 786432;
constexpr size_t WS_X8 = 269 * MiB, WS_MIX8 = 301 * MiB;
constexpr size_t WS_PROJ0 = 421 * MiB, WS_CLOC = 501 * MiB, WS_CPREV = 543 * MiB, WS_H = 585 * MiB, WS_HP = 421 * MiB;
constexpr size_t WS_Z = 697 * MiB, WS_KVR = 729 * MiB, WS_QR = 777 * MiB, WS_KF = 817 * MiB, WS_AP = 697 * MiB, WS_YP = 765 * MiB, WS_END = 853 * MiB;
static_assert((size_t)SLOT_ROWS * FF * 2 <= 276 * MiB && (size_t)SLOT_ROWS * D * 2 <= 68 * MiB && (size_t)1024 * ML_CROWS * ML_DK * 2 <= 42 * MiB, "ws map");
#ifndef MOE_DEP
#define MOE_DEP 0
#endif
#ifndef MOE_ROT
#define MOE_ROT 0
#endif
#ifndef MOE_LT_K
#define MOE_LT_K 3
#endif
constexpr int CW_TMO = 0, CW_BAR = 4096, CW_CNT = 8192, CW_CUR = 9216, CW_CVTQ = 10240;

constexpr int RING_BYTES = 131072, LDSCTL_OFF = RING_BYTES, MISC_OFF = LDSCTL_OFF + 320, LDS_BYTES = 147456;

typedef GAS unsigned gu32;
#define RLX_AGENT __ATOMIC_RELAXED, __HIP_MEMORY_SCOPE_AGENT
#define LDS_WAIT() asm volatile("s_waitcnt lgkmcnt(0)" ::: "memory")
#define VM_WAIT() asm volatile("s_waitcnt vmcnt(0)" ::: "memory")

#define XB_TMO      128
#define XB_XCNT(j)  (256  + 64 * (j))
#define XB_XSUB(j)  (1280 + 64 * (j))
#define XB_XGEN(j)  (2304 + 64 * (j))
#define XB_TOP      3328
#define XB_TOPGEN   3392
#define XCD_BAR_WORDS 3456
#define XB_SPIN_CAP (1u << 18)
__device__ __forceinline__ unsigned xb_ld(unsigned* p)              { return __hip_atomic_load(p, __ATOMIC_RELAXED, __HIP_MEMORY_SCOPE_AGENT); }
__device__ __forceinline__ unsigned xb_add(unsigned* p, unsigned v) { return __hip_atomic_fetch_add(p, v, __ATOMIC_RELAXED, __HIP_MEMORY_SCOPE_AGENT); }
__device__ __forceinline__ unsigned xb_xcc_id() { return (unsigned)__builtin_amdgcn_s_getreg((3 << 11) | 20) & 0xFu; }
#define XB_SPIN(cond, bar) do { unsigned _sp = 0; while (cond) { __builtin_amdgcn_s_sleep(1); \
    if ((++_sp & 255u) == 0u) { if (xb_ld(&(bar)[XB_TMO])) break; if (_sp > XB_SPIN_CAP) { atomicAdd(&(bar)[XB_TMO], 1u); break; } } } } while (0)
struct XcdBarrier { unsigned* bar; unsigned x; volatile LAS unsigned* st; int wave; };
__device__ __forceinline__ int lane_id() { return (int)__builtin_amdgcn_mbcnt_hi(~0u, __builtin_amdgcn_mbcnt_lo(~0u, 0u)); }
__device__ __forceinline__ XcdBarrier xcd_barrier_post(unsigned* bar, volatile LAS unsigned* st) {
    XcdBarrier b; b.bar = bar; b.x = xb_xcc_id(); b.st = st; b.wave = __builtin_amdgcn_readfirstlane((int)threadIdx.x >> 6);
    if (threadIdx.x == 0) (void)xb_add(&bar[XB_XCNT(b.x)], 1u);
    return b;
}
__device__ __forceinline__ void xcd_barrier_complete(unsigned* bar, unsigned x, unsigned& nloc, unsigned& nx) {
    const unsigned G = gridDim.x * gridDim.y * gridDim.z;
    unsigned sum, cnt, mine, sp = 0u;
    for (;;) {
        sum = 0u; cnt = 0u; mine = 0u;
#pragma unroll
        for (unsigned j = 0; j < 16; ++j) { const unsigned c = xb_ld(&bar[XB_XCNT(j)]); sum += c; cnt += (c > 0u) ? 1u : 0u; mine = (j == x) ? c : mine; }
        if (sum == G) break;
        __builtin_amdgcn_s_sleep(1);
        if ((++sp & 255u) == 0u) { if (xb_ld(&bar[XB_TMO])) break; if (sp > XB_SPIN_CAP) { atomicAdd(&bar[XB_TMO], 1u); break; } }
    }
    nloc = mine > 0u ? mine : 1u; nx = cnt > 0u ? cnt : 1u;
}
__device__ __forceinline__ void xcd_barrier(const XcdBarrier& b) {
    asm volatile("s_waitcnt vmcnt(0)" ::: "memory");
    __syncthreads();
    if (b.wave == 0 && lane_id() == 0) {
        unsigned* bar = b.bar;
        __builtin_amdgcn_s_waitcnt(0);
        unsigned nloc = b.st[0], nx = b.st[1];
        if (nloc == 0u) { xcd_barrier_complete(bar, b.x, nloc, nx); b.st[0] = nloc; b.st[1] = nx; }
        const unsigned old = xb_add(&bar[XB_XSUB(b.x)], 1u);
        const unsigned gen = old / nloc;
        if (old + 1u == (gen + 1u) * nloc) {
            __builtin_amdgcn_fence(__ATOMIC_RELEASE, "agent");
            asm volatile("s_waitcnt vmcnt(0)" ::: "memory");
            const unsigned og = xb_add(&bar[XB_TOP], 1u);
            const unsigned tg = og / nx;
            if (og + 1u == (tg + 1u) * nx) xb_add(&bar[XB_TOPGEN], 1u);
            else XB_SPIN(xb_ld(&bar[XB_TOPGEN]) == tg, bar);
            __builtin_amdgcn_fence(__ATOMIC_ACQUIRE, "agent");
            xb_add(&bar[XB_XGEN(b.x)], 1u);
            asm volatile("s_waitcnt vmcnt(0)" ::: "memory");
        } else {
            XB_SPIN(xb_ld(&bar[XB_XGEN(b.x)]) == gen, bar);
            __builtin_amdgcn_fence(__ATOMIC_ACQUIRE, "agent");
            asm volatile("s_waitcnt vmcnt(0)" ::: "memory");
        }
    }
    __syncthreads();
}

#define XA_SUB(s)   (8192 + 2048 * (s))
#define XA_TOP(s)   (8192 + 2048 * (s) + 1024)
__device__ __forceinline__ void xcd_arrive(const XcdBarrier& b, int slot) {
    asm volatile("s_waitcnt vmcnt(0)" ::: "memory");
    __syncthreads();
    if (b.wave == 0 && lane_id() == 0) {
        unsigned* bar = b.bar;
        __builtin_amdgcn_s_waitcnt(0);
        const unsigned nloc = b.st[0];
        const unsigned old = xb_add(&bar[XA_SUB(slot) + 64 * b.x], 1u);
        if (old + 1u == nloc) { __builtin_amdgcn_fence(__ATOMIC_RELEASE, "agent"); asm volatile("s_waitcnt vmcnt(0)" ::: "memory"); xb_add(&bar[XA_TOP(slot)], 1u); }
    }
}
__device__ __forceinline__ void xcd_wait(const XcdBarrier& b, int slot) {
    if (b.wave == 0 && lane_id() == 0) {
        unsigned* bar = b.bar; const unsigned nx = b.st[1];
        XB_SPIN(xb_ld(&bar[XA_TOP(slot)]) < nx, bar);
        __builtin_amdgcn_fence(__ATOMIC_ACQUIRE, "agent");
        asm volatile("s_waitcnt vmcnt(0)" ::: "memory");
    }
    __syncthreads();
}

struct Args { const void* in[29]; float* out; unsigned char* ws; float inv[32]; int ph_lo, ph_hi, dbg, pad; };

struct Frame {
    LAS unsigned char* lds; volatile LAS unsigned* MISC; unsigned* ctl; unsigned char* ws;
    int tid, lane, wave, G, gw, NGW;
};

struct CvtJob { const float* W; const float* gain; bf16* WT; int ldw, K, dst_row0, src_col0, nblk, mode; };
__device__ __forceinline__ int cvt_src_col(const CvtJob& J, int nb) { if ((J.mode & 3) == 1) { const int pn = nb >> 3, j = nb & 7; return ((j < 4) ? 0 : FF) + 128 * pn + 32 * (j & 3); } return J.src_col0 + 32 * nb; }
__device__ __forceinline__ void cvt_load(const CvtJob& J, int item, int lane, f32x4 (&ld)[8]) {
    if ((J.mode & 3) == 2) return;
    const int kb = item / J.nblk, nb = item % J.nblk, k0 = 64 * kb, sc = cvt_src_col(J, nb);
    const float* src = J.W + (size_t)(k0 + (lane >> 3)) * J.ldw + sc + 4 * (lane & 7);
#pragma unroll
    for (int i = 0; i < 8; ++i) ld[i] = __builtin_nontemporal_load((const f32x4*)(src + (size_t)(8 * i) * J.ldw));
}
__device__ __forceinline__ void cvt_finish(const CvtJob& J, int item, LAS float* scr, int lane, const f32x4 (&ld)[8]) {
    const int kb = item / J.nblk, nb = item % J.nblk, k0 = 64 * kb;
    const int c = lane & 7;
    const bool f8 = (J.mode & 4) != 0;
    bf16* dstb = J.WT + (size_t)(J.dst_row0 + 32 * nb) * J.K + k0 + 8 * c;
    if ((J.mode & 3) == 2) {
        if (f8) { unsigned char* z8 = (unsigned char*)J.WT + (size_t)(J.dst_row0 + 32 * nb + (lane >> 1)) * J.K + k0 + 32 * (lane & 1);
            *(u32x4*)z8 = (u32x4){0u, 0u, 0u, 0u}; *(u32x4*)(z8 + 16) = (u32x4){0u, 0u, 0u, 0u}; return; }
#pragma unroll
        for (int j = 0; j < 4; ++j) { const int n = (lane >> 3) + 8 * j; *(u32x4*)(dstb + (size_t)n * J.K) = (u32x4){0u, 0u, 0u, 0u}; }
        return;
    }
#pragma unroll
    for (int i = 0; i < 8; ++i) { LAS float* d = scr + (8 * i + (lane >> 3)) * 33 + 4 * (lane & 7); d[0] = ld[i][0]; d[1] = ld[i][1]; d[2] = ld[i][2]; d[3] = ld[i][3]; }
    LDS_WAIT(); asm volatile("" ::: "memory");
    if (f8) {
        const int c4 = lane & 3; unsigned char* d8 = (unsigned char*)J.WT + (size_t)(J.dst_row0 + 32 * nb) * J.K + k0 + 16 * c4;
        float gk[16];
        const float wsc = ((J.mode & 3) == 1) ? (((nb & 7) < 4) ? 64.0f * 1.4426950408889634f : 64.0f * 4.0f / 1.4426950408889634f) : 64.0f;
#pragma unroll
        for (int i = 0; i < 16; ++i) gk[i] = (J.gain ? J.gain[k0 + 16 * c4 + i] : 1.f) * wsc;
#pragma unroll
        for (int j = 0; j < 2; ++j) { const int n = (lane >> 2) + 16 * j; const LAS float* s = scr + (16 * c4) * 33 + n; u32x4 o;
#pragma unroll
            for (int q = 0; q < 4; ++q) o[q] = pg8::pk4_fp8(s[(4 * q) * 33] * gk[4 * q], s[(4 * q + 1) * 33] * gk[4 * q + 1], s[(4 * q + 2) * 33] * gk[4 * q + 2], s[(4 * q + 3) * 33] * gk[4 * q + 3]);
            *(u32x4*)(d8 + (size_t)n * J.K) = o; }
        LDS_WAIT(); asm volatile("" ::: "memory");
        return; }
    f32x4 g0 = (f32x4){1.f, 1.f, 1.f, 1.f}, g1 = g0;
    if (J.gain) { g0 = *(const f32x4*)(J.gain + k0 + 8 * c); g1 = *(const f32x4*)(J.gain + k0 + 8 * c + 4); }
#pragma unroll
    for (int j = 0; j < 4; ++j) { const int n = (lane >> 3) + 8 * j; const LAS float* s = scr + (8 * c) * 33 + n;
        u32x4 o; o.x = cvtpk(s[0 * 33] * g0[0], s[1 * 33] * g0[1]); o.y = cvtpk(s[2 * 33] * g0[2], s[3 * 33] * g0[3]); o.z = cvtpk(s[4 * 33] * g1[0], s[5 * 33] * g1[1]); o.w = cvtpk(s[6 * 33] * g1[2], s[7 * 33] * g1[3]);
        *(u32x4*)(dstb + (size_t)n * J.K) = o; }
    LDS_WAIT(); asm volatile("" ::: "memory");
}
#define F32IN(i) ((const float*)A.in[i])
#define WSP(T_, off) ((T_*)(F.ws + (off)))
#define CVT_JOB(W_, g_, WT_, ldw_, K_, r0_, c0_, nblk_, mode_) if (!found) { const int n_ = ((K_) / 64) * (nblk_); if (r < n_) { J.W = (W_); J.gain = (g_); J.WT = (WT_); J.ldw = (ldw_); J.K = (K_); J.dst_row0 = (r0_); J.src_col0 = (c0_); J.nblk = (nblk_); J.mode = (mode_); found = true; } else r -= n_; }
constexpr int CVT_SMALL_ITEMS = 16 * 72 + 16 * 8 + 2 * 16 * 16 + 16 * 32 + 16 * 224 + 56 * 32 + 16 * 8 + 16 * 12 + 16 * 2 + 16 * 2 + 16 * 8 + 4 * 48 + 6 * 36 + 6 * 4 + 16 * 32;
constexpr int CVT_GU1_ITEMS = 16 * 224, CVT_D1_ITEMS = 56 * 32, CVT_TOTAL_ITEMS = CVT_SMALL_ITEMS + 8 * (CVT_GU1_ITEMS + CVT_D1_ITEMS);
__device__ __forceinline__ int cvt_lookup(const Args& A, Frame& F, int item, CvtJob& J) {
    J.W = nullptr; J.gain = nullptr; J.WT = nullptr; J.ldw = 0; J.K = 64; J.dst_row0 = 0; J.src_col0 = 0; J.nblk = 1; J.mode = 2;
    bool found = false; int r = item;
    if (r >= CVT_SMALL_ITEMS) { r -= CVT_SMALL_ITEMS;
        if (r < 8 * CVT_GU1_ITEMS) { const int e = r / CVT_GU1_ITEMS; r -= e * CVT_GU1_ITEMS;
            J.W = F32IN(27) + (size_t)e * D * 2 * FF; J.gain = F32IN(23) + D; J.WT = (bf16*)(F.ws + WS_W_GU1 + (size_t)e * 2 * FF * D); J.ldw = 2 * FF; J.K = D; J.nblk = 224; J.mode = 5; }
        else { r -= 8 * CVT_GU1_ITEMS; const int e = r / CVT_D1_ITEMS; r -= e * CVT_D1_ITEMS;
            J.W = F32IN(28) + (size_t)e * FF * D; J.gain = nullptr; J.WT = (bf16*)(F.ws + WS_W_D1 + (size_t)e * D * FF); J.ldw = D; J.K = FF; J.nblk = 32; J.mode = 4; }
        found = true; }
    CVT_JOB(F32IN(4), F32IN(3), WSP(bf16, WS_W_IN0), 2568, 1024, 0, 0, 72, 0)
    CVT_JOB(F32IN(4), F32IN(3), WSP(bf16, WS_W_IN0), 2568, 1024, 2304, 2312, 8, 0)
    CVT_JOB(F32IN(20), F32IN(19), WSP(bf16, WS_W_MEM), 512, 1024, 0, 0, 16, 0)
    CVT_JOB(F32IN(20) + (size_t)D * 512, F32IN(19) + D, WSP(bf16, WS_W_MEM), 512, 1024, 512, 0, 16, 0)
    CVT_JOB(F32IN(7), nullptr, WSP(bf16, WS_W_OUT0), 1024, 1024, 0, 0, 32, 0)
    CVT_JOB(F32IN(24), F32IN(23), WSP(bf16, WS_W_GU0), 2 * FF, 1024, 0, 0, 224, 1)
    CVT_JOB(F32IN(25), nullptr, WSP(bf16, WS_W_D0), 1024, FF, 0, 0, 32, FFN2_FP8 ? 4 : 0)
    CVT_JOB(F32IN(15), F32IN(14), WSP(bf16, WS_W_IN1), 320, 1024, 0, 0, 8, L1_FP8 ? 4 : 0)
    CVT_JOB(F32IN(9), F32IN(8), WSP(bf16, WS_W_IN1), 640, 1024, 256, 0, 12, L1_FP8 ? 4 : 0)
    CVT_JOB(F32IN(15), F32IN(14), WSP(bf16, WS_W_IN1), 320, 1024, 640, 256, 2, L1_FP8 ? 4 : 0)
    CVT_JOB(nullptr, nullptr, WSP(bf16, WS_W_IN1), 0, 1024, 704, 0, 2, L1_FP8 ? 6 : 2)
    CVT_JOB(F32IN(9), F32IN(8), WSP(bf16, WS_W_IN1), 640, 1024, 768, 384, 8, L1_FP8 ? 4 : 0)
    CVT_JOB(F32IN(17), F32IN(16), WSP(bf16, WS_W_UKV), 1536, 256, 0, 0, 48, 0)
    CVT_JOB(F32IN(11), F32IN(10), WSP(bf16, WS_W_UQ), 1152, 384, 0, 0, 36, 0)
    CVT_JOB(nullptr, nullptr, WSP(bf16, WS_W_UQ), 0, 384, 1152, 0, 4, 2)
    CVT_JOB(F32IN(13), nullptr, WSP(bf16, WS_W_OUT1), 1024, 1024, 0, 0, 32, L1_FP8 ? 4 : 0)
    if (!found) { J.mode = 2; J.WT = nullptr; r = -1; }
    return r;
}

constexpr int TBL_OFF = 98304;
__device__ __forceinline__ void fill_tbl8(Frame& F, const float* W, int ldw, int col0, const float* gain) {
    LAS float* tA = (LAS float*)(F.lds + TBL_OFF); LAS float* tB = tA + 4096;
    for (int i = F.tid; i < 1024 * 8; i += NWAVES * 64) { const int k = i >> 3, cc = i & 7, pos = (k & 3) * 256 + (k >> 2); const float v = W[(size_t)k * ldw + col0 + cc] * gain[k];
        if (cc < 4) tA[pos * 4 + cc] = v; else tB[pos * 4 + (cc - 4)] = v; }
    __syncthreads();
}
__device__ __forceinline__ void row_dot8(Frame& F, const f32x4 (&v)[4], float (&dot)[8]) {
    const LAS f32x4* tA = (const LAS f32x4*)(F.lds + TBL_OFF); const LAS f32x4* tB = tA + 1024;
#pragma unroll
    for (int cidx = 0; cidx < 8; ++cidx) dot[cidx] = 0.f;
#pragma unroll
    for (int j = 0; j < 4; ++j)
#pragma unroll
        for (int e = 0; e < 4; ++e) { const int pos = e * 256 + 64 * j + F.lane; const f32x4 a = tA[pos], b = tB[pos]; const float x = v[j][e];
            dot[0] += x * a[0]; dot[1] += x * a[1]; dot[2] += x * a[2]; dot[3] += x * a[3]; dot[4] += x * b[0]; dot[5] += x * b[1]; dot[6] += x * b[2]; dot[7] += x * b[3]; }
#pragma unroll
    for (int cidx = 0; cidx < 8; ++cidx) dot[cidx] = wave_sum(dot[cidx]);
}
__device__ __forceinline__ float row_load_ss(const float* xrow, int lane, f32x4 (&v)[4]) {
    const f32x4* xr = (const f32x4*)xrow + lane; float s = 0.f;
#pragma unroll
    for (int j = 0; j < 4; ++j) { v[j] = __builtin_nontemporal_load(xr + 64 * j); s += (v[j][0] * v[j][0] + v[j][1] * v[j][1]) + (v[j][2] * v[j][2] + v[j][3] * v[j][3]); }
    return wave_sum(s);
}
__device__ __forceinline__ void row_load(const float* xrow, int lane, f32x4 (&v)[4]) {
    const f32x4* xr = (const f32x4*)xrow + lane;
#pragma unroll
    for (int j = 0; j < 4; ++j) v[j] = __builtin_nontemporal_load(xr + 64 * j);
}
__device__ __forceinline__ float row_ss(const f32x4 (&v)[4]) { float s = 0.f;
#pragma unroll
    for (int j = 0; j < 4; ++j) s += (v[j][0] * v[j][0] + v[j][1] * v[j][1]) + (v[j][2] * v[j][2] + v[j][3] * v[j][3]);
    return wave_sum(s);
}
__device__ __forceinline__ void row_load_bf16(const bf16* xrow, int lane, u32x2 (&w)[4]) {
    const u32x2* xr = (const u32x2*)xrow + lane;
#pragma unroll
    for (int j = 0; j < 4; ++j) w[j] = xr[64 * j];
}
__device__ __forceinline__ float row_unpack_ss_bf16(const u32x2 (&w)[4], f32x4 (&v)[4]) { float s = 0.f;
#pragma unroll
    for (int j = 0; j < 4; ++j) { v[j] = (f32x4){bf_lo(w[j].x), bf_hi(w[j].x), bf_lo(w[j].y), bf_hi(w[j].y)}; s += (v[j][0] * v[j][0] + v[j][1] * v[j][1]) + (v[j][2] * v[j][2] + v[j][3] * v[j][3]); }
    return wave_sum(s);
}
__device__ __forceinline__ float row_load_ss_bf16(const bf16* xrow, int lane, f32x4 (&v)[4]) {
    const u32x2* xr = (const u32x2*)xrow + lane; float s = 0.f;
#pragma unroll
    for (int j = 0; j < 4; ++j) { const u32x2 w = xr[64 * j]; v[j] = (f32x4){bf_lo(w.x), bf_hi(w.x), bf_lo(w.y), bf_hi(w.y)}; s += (v[j][0] * v[j][0] + v[j][1] * v[j][1]) + (v[j][2] * v[j][2] + v[j][3] * v[j][3]); }
    return wave_sum(s);
}
__device__ __forceinline__ void row_store_bf16(bf16* orow, int lane, const f32x4 (&v)[4]) {
    u32x2* o8 = (u32x2*)orow + lane;
#pragma unroll
    for (int j = 0; j < 4; ++j) { u32x2 w; w.x = cvtpk(v[j][0], v[j][1]); w.y = cvtpk(v[j][2], v[j][3]); o8[64 * j] = w; }
}

constexpr int CVT_LATE_ITEMS = CVT_TOTAL_ITEMS - CVT_SMALL_ITEMS, CVT_CHUNK = 8;
__device__ __forceinline__ void cvt_queue(const Args& A, Frame& F, int quota) {
    LAS float* scr = (LAS float*)(F.lds + F.wave * 8704);
    for (;;) {
        int h = 0; if (F.lane == 0) h = (int)__hip_atomic_fetch_add(F.ctl + CW_CVTQ, (unsigned)CVT_CHUNK, RLX_AGENT);
        h = __builtin_amdgcn_readfirstlane(h);
        if (h >= CVT_LATE_ITEMS) break;
        const int e = (h + CVT_CHUNK < CVT_LATE_ITEMS) ? h + CVT_CHUNK : CVT_LATE_ITEMS;
        CvtJob Jc; int rc = cvt_lookup(A, F, CVT_SMALL_ITEMS + h, Jc); f32x4 ldc[8]; cvt_load(Jc, rc, F.lane, ldc);
        for (int it = h; it < e; ++it) { CvtJob Jn; int rn = -1; f32x4 ldn[8];
#pragma unroll
            for (int i = 0; i < 8; ++i) ldn[i] = ldc[i];
            if (it + 1 < e) { rn = cvt_lookup(A, F, CVT_SMALL_ITEMS + it + 1, Jn); cvt_load(Jn, rn, F.lane, ldn); }
            cvt_finish(Jc, rc, scr, F.lane, ldc);
            Jc = Jn; rc = rn;
#pragma unroll
            for (int i = 0; i < 8; ++i) ldc[i] = ldn[i]; }
        if (h >= quota) break;
    }
}
#define CVT_QUOTA(pct) ((int)((long)CVT_LATE_ITEMS * (pct) / 100))
enum { PH_PRO = 0, PH_PROJ0, PH_MLA_MEM0, PH_MLB, PH_MLC, PH_OUT0, PH_FFN1, PH_FFN2, PH_IN1, PH_UP1, PH_KFIN_MEM1, PH_ATTN, PH_OUT1, PH_ROUTE, PH_GATHER, PH_MOE1, PH_MOE2, PH_COMBINE, PH_DBG, N_PHASES };
#ifndef MK_ONE_LAUNCH
#define MK_ONE_LAUNCH 0
#endif
#ifndef DBG_MODE
#define DBG_MODE 0
#endif
#ifndef REPEAT_MASK
#define REPEAT_MASK 0u
#endif
#define REPS(k) (1 + (int)((REPEAT_MASK >> (k)) & 1u))
#ifndef DBG_LAST
#define DBG_LAST N_PHASES
#endif

__global__ void __launch_bounds__(NWAVES * 64, 2) fwd_kernel(Args A) {
    extern __shared__ __attribute__((aligned(16))) unsigned char lds_raw[];
    Frame F;
    F.lds = (LAS unsigned char*)lds_raw; F.MISC = (volatile LAS unsigned*)(F.lds + MISC_OFF);
    F.tid = threadIdx.x; F.lane = F.tid & 63; F.wave = __builtin_amdgcn_readfirstlane(F.tid >> 6);
    F.G = gridDim.x; F.ws = A.ws; F.ctl = (unsigned*)(A.ws + WS_CTL);
    { const int bx = blockIdx.x; const int vcu = (F.G % 8 == 0) ? (bx % 8) * (F.G / 8) + bx / 8 : bx; F.gw = vcu * NWAVES + F.wave; F.NGW = F.G * NWAVES; }
    for (int u = F.tid; u < (LDS_BYTES - LDSCTL_OFF) / 4; u += NWAVES * 64) ((LAS unsigned*)(F.lds + LDSCTL_OFF))[u] = 0u;
    __syncthreads();
    const int lo = A.ph_lo, hi = A.ph_hi;
    XcdBarrier bar; bar.bar = F.ctl + CW_BAR; bar.x = 0; bar.st = nullptr; bar.wave = F.wave;
    if (hi - lo > 1) bar = xcd_barrier_post(F.ctl + CW_BAR, F.MISC + 8);
#define IN(k) (lo <= (k) && (k) < hi)
#define PH_BEGIN() do { int t_ = F.wave * 64 + lane_id(); asm volatile("" : "+v"(t_)); F.tid = t_; F.lane = t_ & 63; } while (0)
#ifdef PROBE_DOUBLE_BAR
#define SEAM(k) do { if (IN(k) && IN((k) + 1)) { xcd_barrier(bar); xcd_barrier(bar); } } while (0)
#else
#define SEAM(k) do { if (IN(k) && IN((k) + 1)) xcd_barrier(bar); } while (0)
#endif
    const int bx = blockIdx.x;
    LAS unsigned char* ring = F.lds;

    if (IN(PH_PRO)) for (int rep_ = 0; rep_ < REPS(PH_PRO); ++rep_) { PH_BEGIN();
        LAS float* scr = (LAS float*)(ring + F.wave * 8704);
        { CvtJob Jc; int rc = -1; f32x4 ldc[8];
          if (F.gw < CVT_TOTAL_ITEMS) { rc = cvt_lookup(A, F, F.gw, Jc); if (rc >= 0) cvt_load(Jc, rc, F.lane, ldc); }
          for (int it = F.gw; it < CVT_TOTAL_ITEMS; it += F.NGW) { CvtJob Jn; int rn = -1; f32x4 ldn[8];
#pragma unroll
              for (int i = 0; i < 8; ++i) ldn[i] = ldc[i];
              if (it + F.NGW < CVT_TOTAL_ITEMS) { rn = cvt_lookup(A, F, it + F.NGW, Jn); if (rn >= 0) cvt_load(Jn, rn, F.lane, ldn); }
              if (rc >= 0) cvt_finish(Jc, rc, scr, F.lane, ldc);
              Jc = Jn; rc = rn;
#pragma unroll
              for (int i = 0; i < 8; ++i) ldc[i] = ldn[i]; } }
        __syncthreads();
        fill_tbl8(F, F32IN(4), 2568, 2304, F32IN(3));
        const float* x = F32IN(0); const float* gb = F32IN(5);
        f32x4 vn[4]; if (F.gw < T) row_load(x + (size_t)F.gw * D, F.lane, vn);
        for (int m = F.gw; m < T; m += F.NGW) { f32x4 v[4];
#pragma unroll
            for (int j = 0; j < 4; ++j) v[j] = vn[j];
            if (m + F.NGW < T) row_load(x + (size_t)(m + F.NGW) * D, F.lane, vn);
            const float ss = row_ss(v); const float r = 1.0f / sqrtf(ss * (1.0f / D) + EPS);
            row_store_bf16(WSP(bf16, WS_XB) + (size_t)m * D, F.lane, v);
            float dot[8]; row_dot8(F, v, dot);
            if (F.lane < 8) { float dv = dot[0];
#pragma unroll
                for (int cc = 1; cc < 8; ++cc) dv = (F.lane == cc) ? dot[cc] : dv;
                WSP(float, WS_IFG)[(size_t)m * 8 + F.lane] = dv * r + gb[F.lane]; }
            if (F.lane == 0) WSP(float, WS_R0)[m] = r; }
        const float* mem = F32IN(1);
        for (int m = F.gw; m < NMEMROWS; m += F.NGW) { f32x4 v[4]; const float ss = row_load_ss(mem + (size_t)m * D, F.lane, v);
            row_store_bf16(WSP(bf16, WS_MEMB) + (size_t)m * D, F.lane, v);
            if (F.lane == 0) WSP(float, WS_RM)[m] = 1.0f / sqrtf(ss * (1.0f / D) + EPS); }
        const int* pos = (const int*)A.in[2];
        for (int i = bx * 512 + F.tid; i < T * 32; i += F.G * 512) { const float ang = (float)pos[i >> 5] * A.inv[i & 31]; float sn, cs; sincosf(ang, &sn, &cs); WSP(f32x2, WS_ROPE)[i] = (f32x2){cs, sn}; }
        __syncthreads();
    }
    SEAM(PH_PRO);
    const bool p1dep = (P1_MEMQ != 0) && lo == 0 && IN(PH_PROJ0) && IN(PH_MLA_MEM0) && F.G == 256 && REPS(PH_PROJ0) == 1 && REPS(PH_MLA_MEM0) == 1;
    if (IN(PH_PROJ0)) for (int rep_ = 0; rep_ < REPS(PH_PROJ0); ++rep_) { PH_BEGIN();
      if (p1dep) {
        { pg8::Gemm g{WSP(bf16, WS_XB), WSP(bf16, WS_W_IN0) + (size_t)9 * 256 * D, D, D}; pg8::StaticOrder S; S.init(T / 256, 1, F.G, bx);
          pg8::EpiScaleBf16<0> E{WSP(bf16, WS_PROJ0) + 2304, 2560, pg8::RowScaleT<0>{WSP(float, WS_R0), 0.f}, 1 << 20};
          pg8::gemm_phase(F.tid, ring, g, S, E); }
        { pg8::Gemm g{WSP(bf16, WS_MEMB), WSP(bf16, WS_W_MEM), D, D}; pg8::StaticOrder S; S.init(NMEMROWS / 256, 4, F.G, (bx - 64 + F.G) % F.G);
          pg8::EpiScaleBf16<0> E{WSP(bf16, WS_MEMKV), 1024, pg8::RowScaleT<0>{WSP(float, WS_RM), 0.f}, 1 << 20};
          pg8::gemm_phase(F.tid, ring, g, S, E); }
        xcd_arrive(bar, 2); PH_BEGIN();
        { pg8::Gemm g{WSP(bf16, WS_XB), WSP(bf16, WS_W_IN0), D, D}; pg8::StaticOrder S; S.init(T / 256, 9, F.G, (bx - 96 + F.G) % F.G);
          pg8::EpiScaleBf16<0> E{WSP(bf16, WS_PROJ0), 2560, pg8::RowScaleT<0>{WSP(float, WS_R0), 0.f}, 1 << 20};
          pg8::gemm_phase(F.tid, ring, g, S, E); }
        if (bx >= 160) { xcd_wait(bar, 2); PH_BEGIN();
          for (int u = bx - 160; u < 256; u += 96) { const int b = u >> 5, h = (u >> 3) & 3, qb = u & 7; const size_t row0 = (size_t)b * SEQ + qb * 256;
            attn_unit<64, 64, false, true, false>(F.tid, ring, WSP(bf16, WS_PROJ0) + row0 * 2560 + 2304 + h * 64, 2560, WSP(bf16, WS_MEMKV) + (size_t)b * 256 * 1024 + h * 64, 1024,
                WSP(bf16, WS_MEMKV) + (size_t)b * 256 * 1024 + 256 + h * 64, 1024, WSP(bf16, WS_MIX) + row0 * 1024 + 768 + h * 64, 1024, 4, 0, F32IN(21), F32IN(22), 0.125f * 1.4426950408889634f, nullptr); } }
      } else {
        { pg8::Gemm g{WSP(bf16, WS_XB), WSP(bf16, WS_W_IN0), D, D}; pg8::StaticOrder S; S.init(T / 256, 10, F.G, bx);
          pg8::EpiScaleBf16<0> E{WSP(bf16, WS_PROJ0), 2560, pg8::RowScaleT<0>{WSP(float, WS_R0), 0.f}, 1 << 20};
          pg8::gemm_phase(F.tid, ring, g, S, E); }
        { pg8::Gemm g{WSP(bf16, WS_MEMB), WSP(bf16, WS_W_MEM), D, D}; pg8::StaticOrder S; S.init(NMEMROWS / 256, 4, F.G, (bx + F.G / 2) % F.G);
          pg8::EpiScaleBf16<0> E{WSP(bf16, WS_MEMKV), 1024, pg8::RowScaleT<0>{WSP(float, WS_RM), 0.f}, 1 << 20};
          pg8::gemm_phase(F.tid, ring, g, S, E); }
      }
    }
    SEAM(PH_PROJ0);
    if (IN(PH_MLA_MEM0)) for (int rep_ = 0; rep_ < REPS(PH_MLA_MEM0); ++rep_) { PH_BEGIN();
        mlstm_a_wg(F.tid, ring, bx, F.G, 1024, WSP(bf16, WS_PROJ0), WSP(float, WS_IFG), WSP(bf16, WS_CLOC), WSP(float, WS_GLML));
#if !MEM0_IN_SCAN
        if (!p1dep) for (int u = bx; u < 256; u += F.G) { const int b = u >> 5, h = (u >> 3) & 3, qb = u & 7; const size_t row0 = (size_t)b * SEQ + qb * 256;
            attn_unit<64, 64, false, true, false>(F.tid, ring, WSP(bf16, WS_PROJ0) + row0 * 2560 + 2304 + h * 64, 2560, WSP(bf16, WS_MEMKV) + (size_t)b * 256 * 1024 + h * 64, 1024,
                WSP(bf16, WS_MEMKV) + (size_t)b * 256 * 1024 + 256 + h * 64, 1024, WSP(bf16, WS_MIX) + row0 * 1024 + 768 + h * 64, 1024, 4, 0, F32IN(21), F32IN(22), 0.125f * 1.4426950408889634f, nullptr); }
#endif
    }
    SEAM(PH_MLA_MEM0);
    if (IN(PH_MLB)) for (int rep_ = 0; rep_ < REPS(PH_MLB); ++rep_) { PH_BEGIN(); for (int wi = bx; wi < (ML_SCAN8 ? 256 : 160); wi += F.G) mlstm_b_item(F.tid, wi, WSP(bf16, WS_CLOC), WSP(bf16, WS_CPREV), WSP(float, WS_GLML), WSP(float, WS_MPREV));
#if MEM0_IN_SCAN
        for (int u = (F.G > 160 ? bx - 160 : bx); u >= 0 && u < 256; u += (F.G > 160 ? F.G - 160 : F.G)) { const int b = u >> 5, h = (u >> 3) & 3, qb = u & 7; const size_t row0 = (size_t)b * SEQ + qb * 256;
            attn_unit<64, 64, false, true, false>(F.tid, ring, WSP(bf16, WS_PROJ0) + row0 * 2560 + 2304 + h * 64, 2560, WSP(bf16, WS_MEMKV) + (size_t)b * 256 * 1024 + h * 64, 1024,
                WSP(bf16, WS_MEMKV) + (size_t)b * 256 * 1024 + 256 + h * 64, 1024, WSP(bf16, WS_MIX) + row0 * 1024 + 768 + h * 64, 1024, 4, 0, F32IN(21), F32IN(22), 0.125f * 1.4426950408889634f, nullptr); }
#endif
    }
    SEAM(PH_MLB);
    if (IN(PH_MLC)) for (int rep_ = 0; rep_ < REPS(PH_MLC); ++rep_) { PH_BEGIN(); for (int gi = bx; gi < 256; gi += F.G) mlstm_c_group(F.tid, ring, gi * 4, WSP(bf16, WS_PROJ0), WSP(float, WS_IFG), WSP(bf16, WS_CPREV), WSP(float, WS_MPREV), F32IN(6), WSP(bf16, WS_MIX)); }
    SEAM(PH_MLC);
    if (IN(PH_OUT0)) for (int rep_ = 0; rep_ < REPS(PH_OUT0); ++rep_) { PH_BEGIN();
        pg8::Gemm g{WSP(bf16, WS_MIX), WSP(bf16, WS_W_OUT0), D, D}; pg8::StaticOrder S; S.init(T / 256, 4, F.G, bx);
        pg8::EpiResidualBf16 E{WSP(bf16, WS_XB), WSP(float, WS_SS), D, nullptr};
        pg8::gemm_phase(F.tid, ring, g, S, E);
    }
    SEAM(PH_OUT0);
    if (IN(PH_FFN1)) for (int rep_ = 0; rep_ < REPS(PH_FFN1); ++rep_) { PH_BEGIN();
        pg8::Gemm g{WSP(bf16, WS_XB), WSP(bf16, WS_W_GU0), D, D}; pg8::StaticOrder S; S.init(T / 256, 28, F.G, bx);
#if FFN2_FP8
        pg8::EpiSwiGLU<true, 16> E{WSP(bf16, WS_H), FF, pg8::RowScaleT<16>{WSP(float, WS_SS), 1.0f / D}, 1 << 20, 4.f};
#else
        pg8::EpiSwiGLU<false, 16> E{WSP(bf16, WS_H), FF, pg8::RowScaleT<16>{WSP(float, WS_SS), 1.0f / D}, 1 << 20, 1.f};
#endif
        pg8::gemm_phase(F.tid, ring, g, S, E);
    }
    SEAM(PH_FFN1);
    if (IN(PH_FFN2)) for (int rep_ = 0; rep_ < REPS(PH_FFN2); ++rep_) { PH_BEGIN();
#if FFN2_FP8
        pg8::Gemm g{WSP(bf16, WS_H), WSP(bf16, WS_W_D0), FF / 2, FF / 2}; pg8::StaticOrder S; S.init(T / 256, 4, F.G, bx);
        pg8::EpiResidualBf16T<0x77777777u, 2, L1_FP8 != 0> E{WSP(bf16, WS_XB), WSP(float, WS_SS), D, F.ws + WS_X8};
        pg8::gemm_phase<decltype(E), decltype(S), true, true, false>(F.tid, ring, g, S, E);
#else
        pg8::Gemm g{WSP(bf16, WS_H), WSP(bf16, WS_W_D0), FF, FF}; pg8::StaticOrder S; S.init(T / 256, 4, F.G, bx);
        pg8::EpiResidualBf16T<0x7F7F7F7Fu, 4, L1_FP8 != 0> E{WSP(bf16, WS_XB), WSP(float, WS_SS), D, F.ws + WS_X8};
        pg8::gemm_phase(F.tid, ring, g, S, E);
#endif
    }
    SEAM(PH_FFN2);
    if (IN(PH_IN1)) for (int rep_ = 0; rep_ < REPS(PH_IN1); ++rep_) { PH_BEGIN();
#if L1_FP8
        pg8::Gemm g{WSP(bf16, WS_X8), WSP(bf16, WS_W_IN1), D / 2, D / 2}; pg8::StaticOrder S; S.init(T / 256, 4, F.G, bx);
        pg8::EpiInProj1T<0x79797979u> E{WSP(bf16, WS_Z), 1024, pg8::RowScaleT<16>{WSP(float, WS_SS), 1.0f / D}, WSP(float, WS_SSKV), WSP(float, WS_SSQ)};
        pg8::gemm_phase<decltype(E), decltype(S), true, true, false>(F.tid, ring, g, S, E);
#else
        pg8::Gemm g{WSP(bf16, WS_XB), WSP(bf16, WS_W_IN1), D, D}; pg8::StaticOrder S; S.init(T / 256, 4, F.G, bx);
        pg8::EpiInProj1 E{WSP(bf16, WS_Z), 1024, pg8::RowScaleT<16>{WSP(float, WS_SS), 1.0f / D}, WSP(float, WS_SSKV), WSP(float, WS_SSQ)};
        pg8::gemm_phase(F.tid, ring, g, S, E);
#endif
    }
    SEAM(PH_IN1);
    if (IN(PH_UP1)) for (int rep_ = 0; rep_ < REPS(PH_UP1); ++rep_) { PH_BEGIN();
        { pg8::Gemm g{WSP(bf16, WS_Z), WSP(bf16, WS_W_UKV), 1024, 256}; pg8::StaticOrder S; S.init(T / 256, 6, F.G, bx);
#if KFIN_FUSED
          pg8::EpiKvUp E{WSP(bf16, WS_KVR), 1536, pg8::RowScaleT<4>{WSP(float, WS_SSKV), 1.0f / 256}, WSP(bf16, WS_Z), WSP(float, WS_ROPE), F32IN(18), WSP(bf16, WS_KF), 11};
#else
          pg8::EpiScaleBf16<4> E{WSP(bf16, WS_KVR), 1536, pg8::RowScaleT<4>{WSP(float, WS_SSKV), 1.0f / 256}, 1 << 20};
#endif
          pg8::gemm_phase<decltype(E), decltype(S), false, true, true, false>(F.tid, ring, g, S, E); }
        { pg8::Gemm g{WSP(bf16, WS_Z) + 256, WSP(bf16, WS_W_UQ), 1024, 384}; pg8::StaticOrder S; S.init(T / 256, 5, F.G, (bx + F.G / 2) % F.G);
          pg8::EpiScaleBf16<8> E{WSP(bf16, WS_QR), 1280, pg8::RowScaleT<8>{WSP(float, WS_SSQ), 1.0f / 384}, 1 << 20};
          pg8::gemm_phase<decltype(E), decltype(S), false, true, true, false>(F.tid, ring, g, S, E); }
    }
    SEAM(PH_UP1);
#if !KFIN_FUSED
    if (IN(PH_KFIN_MEM1)) for (int rep_ = 0; rep_ < REPS(PH_KFIN_MEM1); ++rep_) { PH_BEGIN();
        const float* kg = F32IN(18);
        const float gr = kg[128 + F.lane]; const f32x2 gn = *(const f32x2*)(kg + 2 * F.lane);
        unsigned krn = 0u, wn[6]; f32x2 csn = (f32x2){0.f, 0.f};
#define KFIN_LOAD(m_) do { krn = (unsigned)WSP(bf16, WS_Z)[(size_t)(m_) * 1024 + 640 + F.lane]; csn = WSP(f32x2, WS_ROPE)[(size_t)(m_) * 32 + (F.lane & 31)]; \
            _Pragma("unroll") for (int h_ = 0; h_ < 6; ++h_) wn[h_] = __builtin_nontemporal_load((const unsigned*)(WSP(bf16, WS_KVR) + (size_t)(m_) * 1536 + h_ * 256 + 2 * F.lane)); } while (0)
        if (F.gw < T) KFIN_LOAD(F.gw);
        for (int m = F.gw; m < T; m += F.NGW) { const int b = m >> 11, s = m & 2047;
            const float kr = __uint_as_float(krn << 16); const f32x2 cs = csn; unsigned wc_[6];
#pragma unroll
            for (int h = 0; h < 6; ++h) wc_[h] = wn[h];
            if (m + F.NGW < T) KFIN_LOAD(m + F.NGW);
#pragma unroll
            for (int h = 0; h < 6; ++h) { const unsigned w = wc_[h]; const float a = bf_lo(w), c2 = bf_hi(w);
                const float ss = wave_sum(a * a + c2 * c2 + kr * kr); const float rk = 1.0f / sqrtf(ss * (1.0f / 192) + EPS);
                bf16* ko = WSP(bf16, WS_KF) + ((size_t)(b * 6 + h) * SEQ + s) * 192;
                *(unsigned*)(ko + 2 * F.lane) = cvtpk(a * rk * gn.x, c2 * rk * gn.y);
                const float y = kr * rk * gr, yp = __shfl_xor(y, 32); const float o_ = (F.lane < 32) ? (y * cs.x - yp * cs.y) : (y * cs.x + yp * cs.y);
                ko[128 + F.lane] = (bf16)(cvtpk(o_, 0.f) & 0xffffu); } }
#undef KFIN_LOAD
    }
    SEAM(PH_KFIN_MEM1);
#endif
    if (IN(PH_ATTN)) for (int rep_ = 0; rep_ < REPS(PH_ATTN); ++rep_) { PH_BEGIN();
        for (int bin = bx; bin < 240; bin += F.G) { const int grp = bin / 48, bh = bin % 48; const int qa = 7 - grp, qbb = (grp >= 1 && grp <= 3) ? grp - 1 : -1;
            for (int pass = 0; pass < 2; ++pass) { const int qb = pass ? qbb : qa; if (qb < 0) break;
                const int b = bh / 6, h = bh % 6; const size_t row0 = (size_t)b * SEQ + qb * 256;
                attn_unit<192, 128, true, false, true, L1_FP8 != 0>(F.tid, ring, WSP(bf16, WS_QR) + row0 * 1280 + h * 192, 1280, WSP(bf16, WS_KF) + (size_t)(b * 6 + h) * SEQ * 192, 192,
                    WSP(bf16, WS_KVR) + (size_t)b * SEQ * 1536 + h * 256 + 128, 1536, L1_FP8 ? (bf16*)(F.ws + WS_MIX8 + row0 * 1024 + h * 128) : WSP(bf16, WS_MIX) + row0 * 1024 + h * 128, 1024, 4 * (qb + 1), qb * 256, F32IN(12), nullptr,
                    0.07216878364870322f * 1.4426950408889634f, WSP(f32x2, WS_ROPE) + row0 * 32); } }
        for (int u = (F.G >= 256 ? (bx >= 240 ? (bx - 240) * 8 : (bx >= 192 ? 128 + (bx - 192) * 3 : 256)) : bx), ue = (F.G >= 256 ? (bx >= 240 ? u + 8 : (u + 3 < 256 ? u + 3 : 256)) : 256); u < ue; u += (F.G >= 256 ? 1 : F.G)) { const int b = u >> 5, h = (u >> 3) & 3, qb = u & 7; const size_t row0 = (size_t)b * SEQ + qb * 256;
            attn_unit<64, 64, false, true, false, L1_FP8 != 0>(F.tid, ring, WSP(bf16, WS_Z) + row0 * 1024 + 768 + h * 64, 1024, WSP(bf16, WS_MEMKV) + (size_t)b * 256 * 1024 + 512 + h * 64, 1024,
                WSP(bf16, WS_MEMKV) + (size_t)b * 256 * 1024 + 768 + h * 64, 1024, L1_FP8 ? (bf16*)(F.ws + WS_MIX8 + row0 * 1024 + 768 + h * 64) : WSP(bf16, WS_MIX) + row0 * 1024 + 768 + h * 64, 1024, 4, 0, F32IN(21) + 64, F32IN(22) + 64, 0.125f * 1.4426950408889634f, nullptr); }
    }
    SEAM(PH_ATTN);
    if (IN(PH_OUT1)) for (int rep_ = 0; rep_ < REPS(PH_OUT1); ++rep_) { PH_BEGIN();
#if L1_FP8
        pg8::Gemm g{WSP(bf16, WS_MIX8), WSP(bf16, WS_W_OUT1), D / 2, D / 2}; pg8::StaticOrder S; S.init(T / 256, 4, F.G, bx);
        pg8::EpiResidualBf16T<0x79797979u, 2> E{WSP(bf16, WS_XB), WSP(float, WS_SS), D, nullptr};
        pg8::gemm_phase<decltype(E), decltype(S), true, true, false>(F.tid, ring, g, S, E);
#else
        pg8::Gemm g{WSP(bf16, WS_MIX), WSP(bf16, WS_W_OUT1), D, D}; pg8::StaticOrder S; S.init(T / 256, 4, F.G, bx);
        pg8::EpiResidualBf16 E{WSP(bf16, WS_XB), WSP(float, WS_SS), D, nullptr};
        pg8::gemm_phase(F.tid, ring, g, S, E);
#endif
    }
    SEAM(PH_OUT1);
    if (IN(PH_ROUTE)) { PH_BEGIN();
        fill_tbl8(F, F32IN(26), 8, 0, F32IN(23) + D);
        LAS unsigned* lcnt = (LAS unsigned*)(F.lds + 65536);
        if (F.tid < 8) lcnt[F.tid] = 0u;
        __syncthreads();
        u32x2 xwn[4]; if (F.gw < T) row_load_bf16(WSP(bf16, WS_XB) + (size_t)F.gw * D, F.lane, xwn);
        for (int m = F.gw; m < T; m += F.NGW) { f32x4 v[4]; u32x2 xwc[4];
#pragma unroll
            for (int j = 0; j < 4; ++j) xwc[j] = xwn[j];
            if (m + F.NGW < T) row_load_bf16(WSP(bf16, WS_XB) + (size_t)(m + F.NGW) * D, F.lane, xwn);
            const float ss = row_unpack_ss_bf16(xwc, v); const float r = 1.0f / sqrtf(ss * (1.0f / D) + EPS);
            float dot[8]; row_dot8(F, v, dot);
            int e1 = 0; float v1 = dot[0];
#pragma unroll
            for (int cc = 1; cc < 8; ++cc) if (dot[cc] > v1) { v1 = dot[cc]; e1 = cc; }
            int e2 = -1; float v2 = -__builtin_inff();
#pragma unroll
            for (int cc = 0; cc < 8; ++cc) if (cc != e1 && dot[cc] > v2) { v2 = dot[cc]; e2 = cc; }
            const float g1 = 1.0f / (1.0f + expf((v2 - v1) * r)), g2 = 1.0f - g1;
            if (F.lane == 0) { *(u32x4*)(WSP(unsigned, WS_TOPK) + (size_t)m * 4) = (u32x4){(unsigned)e1, (unsigned)e2, __float_as_uint(g1), __float_as_uint(g2)}; WSP(float, WS_RS3)[m] = r;
                atomicAdd((unsigned*)&lcnt[e1], 1u); atomicAdd((unsigned*)&lcnt[e2], 1u); } }
        __syncthreads();
        if (F.tid < 8 && lcnt[F.tid]) __hip_atomic_fetch_add(F.ctl + CW_CNT + 64 * F.tid, lcnt[F.tid], RLX_AGENT);
        __syncthreads();
    }
    SEAM(PH_ROUTE);
    if (IN(PH_GATHER)) { PH_BEGIN();
        LAS unsigned* lc = (LAS unsigned*)(F.lds + 65536);
        if (F.tid < 8) { lc[F.tid] = 0u; unsigned tb = 0u; for (int e = 0; e < F.tid; ++e) tb += (__hip_atomic_load(F.ctl + CW_CNT + 64 * e, RLX_AGENT) + 255u) >> 8; lc[16 + F.tid] = tb * 256u; }
        __syncthreads();
        for (int t0 = bx * 64; t0 < T; t0 += F.G * 64) {
            unsigned e1 = 0, e2 = 0, r1 = 0, r2 = 0; float g1 = 0.f, g2 = 0.f;
            if (F.tid < 64) { const u32x4 tk = *(const u32x4*)(WSP(unsigned, WS_TOPK) + (size_t)(t0 + F.tid) * 4); e1 = tk.x; e2 = tk.y; g1 = __uint_as_float(tk.z); g2 = __uint_as_float(tk.w);
                r1 = atomicAdd((unsigned*)&lc[e1], 1u); r2 = atomicAdd((unsigned*)&lc[e2], 1u); }
            __syncthreads();
            if (F.tid < 8) lc[8 + F.tid] = lc[F.tid] ? __hip_atomic_fetch_add(F.ctl + CW_CUR + 64 * F.tid, lc[F.tid], RLX_AGENT) : 0u;
            __syncthreads();
            if (F.tid < 64) { const int tok = t0 + F.tid; const unsigned s1 = lc[16 + e1] + lc[8 + e1] + r1, s2 = lc[16 + e2] + lc[8 + e2] + r2; const float r = WSP(float, WS_RS3)[tok];
                WSP(int, WS_SLOT_TOK)[s1] = tok; WSP(int, WS_SLOT_TOK)[s2] = tok; WSP(float, WS_SLOT_GATE)[s1] = g1 * ((YP_FP8 ? 16.0f : 1.0f) / 256.0f); WSP(float, WS_SLOT_GATE)[s2] = g2 * ((YP_FP8 ? 16.0f : 1.0f) / 256.0f); WSP(float, WS_SLOT_RS)[s1] = r * (1.0f / 64.0f); WSP(float, WS_SLOT_RS)[s2] = r * (1.0f / 64.0f);
                WSP(unsigned, WS_TOK_SLOT)[(size_t)tok * 2] = s1; WSP(unsigned, WS_TOK_SLOT)[(size_t)tok * 2 + 1] = s2; lc[32 + 2 * F.tid] = s1; lc[32 + 2 * F.tid + 1] = s2; }
            __syncthreads();
            for (int i0 = F.wave; i0 < 128; i0 += 4 * NWAVES) { u32x4 ga[4], gb[4]; unsigned gsl[4]; float grs[4];
#pragma unroll
                for (int q = 0; q < 4; ++q) { const int i = i0 + q * NWAVES; gsl[q] = lc[32 + i]; const int tok = t0 + (i >> 1); grs[q] = WSP(float, WS_RS3)[tok];
                    const u32x4* src = (const u32x4*)(WSP(bf16, WS_XB) + (size_t)tok * D) + 2 * F.lane; ga[q] = src[0]; gb[q] = src[1]; }
#pragma unroll
                for (int q = 0; q < 4; ++q) { const u32x4 a = ga[q], b = gb[q]; const float rr = grs[q];
                    u32x4 o; o.x = pg8::pk4_fp8(bf_lo(a.x) * rr, bf_hi(a.x) * rr, bf_lo(a.y) * rr, bf_hi(a.y) * rr); o.y = pg8::pk4_fp8(bf_lo(a.z) * rr, bf_hi(a.z) * rr, bf_lo(a.w) * rr, bf_hi(a.w) * rr);
                    o.z = pg8::pk4_fp8(bf_lo(b.x) * rr, bf_hi(b.x) * rr, bf_lo(b.y) * rr, bf_hi(b.y) * rr); o.w = pg8::pk4_fp8(bf_lo(b.z) * rr, bf_hi(b.z) * rr, bf_lo(b.w) * rr, bf_hi(b.w) * rr);
                    ((u32x4*)((unsigned char*)WSP(bf16, WS_AP) + (size_t)gsl[q] * D))[F.lane] = o; } }
            __syncthreads();
            if (F.tid < 8) lc[F.tid] = 0u;
            __syncthreads();
        }
    }
    SEAM(PH_GATHER);
    if (IN(PH_MOE1) || IN(PH_MOE2)) { PH_BEGIN();
        pg8::MoeOrder S; int tot = 0;
#pragma unroll
        for (int e = 0; e < 8; ++e) { tot += (int)((__hip_atomic_load(F.ctl + CW_CNT + 64 * e, RLX_AGENT) + 255u) >> 8); S.tend[e] = tot; }
        const bool dep = (MOE_DEP != 0) && lo == 0 && IN(PH_MOE1) && IN(PH_MOE2) && F.G == 256 && REPS(PH_MOE1) == 1 && REPS(PH_MOE2) == 1;
        const int nwg1 = tot * 28, nr1 = (nwg1 + F.G - 1) / F.G, n15 = nwg1 - (nr1 - 1) * F.G, sh = (n15 + 7) & ~7;
        const int nwg2 = tot * 4, nr2 = (nwg2 + F.G - 1) / F.G, n3r = (nwg2 - (nr2 - 1) * F.G + 7) & ~7;
        int ltk = 0;
        if (dep && sh + n3r <= F.G) { ltk = (F.G - sh - n3r) / n3r; ltk = ltk < MOE_LT_K ? ltk : MOE_LT_K; ltk = ltk < nr1 - 3 ? ltk : nr1 - 3; ltk = ltk > 0 ? ltk : 0; }
        const int Ra = ltk ? nr1 - 1 - ltk : (nr1 > 2 ? nr1 - 2 : 0);
        if (IN(PH_MOE1)) for (int rep_ = 0; rep_ < REPS(PH_MOE1); ++rep_) { PH_BEGIN();
            pg8::Gemm g{WSP(bf16, WS_AP), WSP(bf16, WS_W_GU1), D / 2, D / 2}; S.so.init(tot, 28, F.G, bx);
            pg8::EpiSwiGLUFold E{(unsigned char*)WSP(bf16, WS_HP), FF, 28};
            S.lt_lo = sh; S.lt_n = n3r; S.lt_k = ltk; S.lt_r = nr1 - 1 - ltk;
#pragma unroll 1
            for (int part = 0; part < (dep ? 2 : 1); ++part) { PH_BEGIN();
                S.r0 = part ? Ra : 0; S.r1 = (dep && !part) ? Ra : 0x3fffffff;
                pg8::gemm_phase<pg8::EpiSwiGLUFold, pg8::MoeOrder, true, true, false>(F.tid, ring, g, S, E);
                if (dep) xcd_arrive(bar, part);
            }
            S.r0 = 0; S.r1 = 0x3fffffff; S.lt_k = 0;
        }
        if (!dep) SEAM(PH_MOE1);
        if (IN(PH_MOE2)) for (int rep_ = 0; rep_ < REPS(PH_MOE2); ++rep_) { PH_BEGIN();
            int c2 = bx, early = 0;
            if (dep) c2 = (bx - (sh % F.G) + F.G) % F.G;
            pg8::Gemm g{WSP(bf16, WS_HP), WSP(bf16, WS_W_D1), FF / 2, FF / 2}; S.so.init(tot, 4, F.G, c2);
            if (dep) { S.rot = MOE_ROT; S.rot_lim = nr2 - 1; }
            if (dep) { const int q1 = nwg1 / 8, rr1 = nwg1 % 8, nig1 = pg8::WGM * 28;
                int ek[2];
#pragma unroll
                for (int k = 0; k < 2; ++k) { pg8::Unit u; ek[k] = 0;
                    if (S.unit_at(k, u)) { const int w0 = (u.pm / pg8::WGM) * nig1, w1 = (w0 + nig1 < nwg1 ? w0 + nig1 : nwg1) - 1;
                        const int x0 = w0 < rr1 * (q1 + 1) ? w0 / (q1 + 1) : rr1 + (w0 - rr1 * (q1 + 1)) / q1;
                        const int x1 = w1 < rr1 * (q1 + 1) ? w1 / (q1 + 1) : rr1 + (w1 - rr1 * (q1 + 1)) / q1;
                        const int o1 = w1 < rr1 * (q1 + 1) ? w1 % (q1 + 1) : (w1 - rr1 * (q1 + 1)) % q1;
                        ek[k] = (x0 == x1 && o1 / (F.G / 8) < Ra) ? 1 : 0; } }
                early = ek[0] ? 1 + ek[1] : ek[1]; S.sw = (!ek[0] && ek[1]) ? 1 : 0; }
#if YP_FP8
            pg8::EpiScaleF8<0> E{F.ws + WS_YP, 1024, pg8::RowScaleT<0>{WSP(float, WS_SLOT_GATE), 0.f}, 4};
#else
            pg8::EpiScaleBf16<0> E{WSP(bf16, WS_YP), 1024, pg8::RowScaleT<0>{WSP(float, WS_SLOT_GATE), 0.f}, 4};
#endif
#pragma unroll 1
            for (int part = 0; part < (dep ? 2 : 1); ++part) { PH_BEGIN();
                if (dep) { if (part == 0) { if (!early) continue; xcd_wait(bar, 0); S.r0 = 0; S.r1 = early; } else { if (early >= nr2 - 1 && c2 >= nwg2 - (nr2 - 1) * F.G) continue; xcd_wait(bar, 1); S.r0 = early; S.r1 = 0x3fffffff; } }
#if YP_FP8
                pg8::gemm_phase<pg8::EpiScaleF8<0>, pg8::MoeOrder, true, true, false>(F.tid, ring, g, S, E);
#else
                pg8::gemm_phase<pg8::EpiScaleBf16<0>, pg8::MoeOrder, true, true, false>(F.tid, ring, g, S, E);
#endif
            }
        }
    }
    SEAM(PH_MOE2);
    if (IN(PH_COMBINE)) for (int rep_ = 0; rep_ < REPS(PH_COMBINE); ++rep_) { PH_BEGIN();
#if YP_FP8
        u32x2 sn = (u32x2){0u, 0u}, xn[4]; unsigned an[4], bn[4];
#define CMB_SLOTS(m_) (*(const u32x2*)(WSP(unsigned, WS_TOK_SLOT) + (size_t)(m_) * 2))
#define CMB_ROWS(m_, sl_) do { const u32x2* xr_ = (const u32x2*)(WSP(bf16, WS_XB) + (size_t)(m_) * D) + F.lane; const unsigned* y1_ = (const unsigned*)(F.ws + WS_YP + (size_t)(sl_).x * D) + F.lane; const unsigned* y2_ = (const unsigned*)(F.ws + WS_YP + (size_t)(sl_).y * D) + F.lane; \
            _Pragma("unroll") for (int j_ = 0; j_ < 4; ++j_) { xn[j_] = __builtin_nontemporal_load(xr_ + 64 * j_); an[j_] = __builtin_nontemporal_load(y1_ + 64 * j_); bn[j_] = __builtin_nontemporal_load(y2_ + 64 * j_); } } while (0)
#define CMB_Y(w_, k_) ((k_) < 2 ? __builtin_amdgcn_cvt_pk_f32_fp8((int)(w_), false)[(k_) & 1] : __builtin_amdgcn_cvt_pk_f32_fp8((int)(w_), true)[(k_) & 1])
#else
        u32x2 sn = (u32x2){0u, 0u}, xn[4], an[4], bn[4];
#define CMB_SLOTS(m_) (*(const u32x2*)(WSP(unsigned, WS_TOK_SLOT) + (size_t)(m_) * 2))
#define CMB_ROWS(m_, sl_) do { const u32x2* xr_ = (const u32x2*)(WSP(bf16, WS_XB) + (size_t)(m_) * D) + F.lane; const u32x2* y1_ = (const u32x2*)(WSP(bf16, WS_YP) + (size_t)(sl_).x * D) + F.lane; const u32x2* y2_ = (const u32x2*)(WSP(bf16, WS_YP) + (size_t)(sl_).y * D) + F.lane; \
            _Pragma("unroll") for (int j_ = 0; j_ < 4; ++j_) { xn[j_] = __builtin_nontemporal_load(xr_ + 64 * j_); an[j_] = __builtin_nontemporal_load(y1_ + 64 * j_); bn[j_] = __builtin_nontemporal_load(y2_ + 64 * j_); } } while (0)
#endif
        if (F.gw < T) { const u32x2 s0 = CMB_SLOTS(F.gw); if (F.gw + F.NGW < T) sn = CMB_SLOTS(F.gw + F.NGW); CMB_ROWS(F.gw, s0); }
        for (int m = F.gw; m < T; m += F.NGW) { u32x2 xc[4];
#if YP_FP8
            unsigned ac[4], bc[4];
#else
            u32x2 ac[4], bc[4];
#endif
#pragma unroll
            for (int j = 0; j < 4; ++j) { xc[j] = xn[j]; ac[j] = an[j]; bc[j] = bn[j]; }
            if (m + F.NGW < T) { const u32x2 s1 = sn; if (m + 2 * F.NGW < T) sn = CMB_SLOTS(m + 2 * F.NGW); CMB_ROWS(m + F.NGW, s1); }
            f32x4* o = (f32x4*)(A.out + (size_t)m * D) + F.lane;
#pragma unroll
#if YP_FP8
            for (int j = 0; j < 4; ++j) { const u32x2 xw = xc[j]; const f32x4 xv = (f32x4){bf_lo(xw.x), bf_hi(xw.x), bf_lo(xw.y), bf_hi(xw.y)};
                const f32x2 a0 = __builtin_amdgcn_cvt_pk_f32_fp8((int)ac[j], false), a1 = __builtin_amdgcn_cvt_pk_f32_fp8((int)ac[j], true), b0 = __builtin_amdgcn_cvt_pk_f32_fp8((int)bc[j], false), b1 = __builtin_amdgcn_cvt_pk_f32_fp8((int)bc[j], true);
                __builtin_nontemporal_store((f32x4){xv[0] + (a0.x + b0.x) * 0.0625f, xv[1] + (a0.y + b0.y) * 0.0625f, xv[2] + (a1.x + b1.x) * 0.0625f, xv[3] + (a1.y + b1.y) * 0.0625f}, o + 64 * j); } }
#else
            for (int j = 0; j < 4; ++j) { const u32x2 xw = xc[j]; const f32x4 xv = (f32x4){bf_lo(xw.x), bf_hi(xw.x), bf_lo(xw.y), bf_hi(xw.y)}; const u32x2 a = ac[j], b2 = bc[j];
                __builtin_nontemporal_store((f32x4){xv[0] + bf_lo(a.x) + bf_lo(b2.x), xv[1] + bf_hi(a.x) + bf_hi(b2.x), xv[2] + bf_lo(a.y) + bf_lo(b2.y), xv[3] + bf_hi(a.y) + bf_hi(b2.y)}, o + 64 * j); } }
#endif
#undef CMB_SLOTS
#undef CMB_ROWS
#ifdef CMB_Y
#undef CMB_Y
#endif
    }
    if (IN(PH_DBG)) { PH_BEGIN();
        const size_t NOUT = (size_t)T * D;
        if (A.dbg < 10) { const float* src = (A.dbg == 1) ? WSP(float, WS_XA) : (A.dbg == 2) ? WSP(float, WS_XC) : F32IN(0);
            for (size_t i = (size_t)bx * 512 + F.tid; i < NOUT; i += (size_t)F.G * 512) { const float v = src[i]; A.out[i] = (v - v == 0.f) ? v : 1e3f; } }
        else { const int k = A.dbg - 10; size_t off = WS_XB, n = NOUT;
            if (k == 1) { off = WS_PROJ0; n = (size_t)T * 2560; } if (k == 2) { off = WS_MEMKV; n = (size_t)NMEMROWS * 1024; } if (k == 3) { off = WS_MIX; n = NOUT; }
            if (k == 4) { off = WS_CLOC; n = (size_t)1024 * ML_CROWS * ML_DK; } if (k == 5) { off = WS_W_IN0; n = (size_t)2560 * 1024; } if (k == 6) { off = WS_W_OUT0; n = (size_t)1024 * 1024; }
            if (k == 7) { off = WS_H; n = (size_t)T * FF; } if (k == 8) { off = WS_Z; n = NOUT; } if (k == 9) { off = WS_KVR; n = (size_t)T * 1536; } if (k == 10) { off = WS_QR; n = (size_t)T * 1280; }
            if (k == 11) { off = WS_KF; n = (size_t)T * 6 * 192; } if (k == 12) { off = WS_W_MEM; n = (size_t)1024 * 1024; } if (k == 13) { off = WS_MEMB; n = (size_t)NMEMROWS * 1024; }
            const bf16* buf = WSP(bf16, off); const float* x = F32IN(0);
            for (size_t i = (size_t)bx * 512 + F.tid; i < NOUT; i += (size_t)F.G * 512) { bool bad = false;
                for (size_t j = i; j < n; j += NOUT) { const unsigned short h = buf[j]; bad |= ((h & 0x7f80u) == 0x7f80u); }
                if (k == 17) { bad = false; if (i < (size_t)T * 8) { const float v = WSP(float, WS_IFG)[i]; bad = !(v - v == 0.f) || fabsf(v) > 50.f; } else if (i < (size_t)T * 8 + 2048) { const float v = WSP(float, WS_GLML)[i - (size_t)T * 8]; bad = !(v - v == 0.f) || fabsf(v) > 200.f; } else if (i < (size_t)T * 9 + 2048) { const float v = WSP(float, WS_R0)[i - (size_t)T * 8 - 2048]; bad = !(v - v == 0.f) || v > 2.f || v < 0.5f; } }
                if (k == 15) { const unsigned short h = WSP(bf16, WS_MIX)[i]; bad = ((i & 1023) >= 768) && ((h & 0x7f80u) == 0x7f80u); }
                if (k == 16) { const unsigned short h = WSP(bf16, WS_MIX)[i]; bad = ((i & 1023) < 768) && ((h & 0x7f80u) == 0x7f80u); }
                A.out[i] = x[i] + (bad ? 1e3f : 0.f); } }
    }
#undef IN
#undef SEAM
}

extern "C" void kernel_launch(void* const* d_in, const int* in_sizes, int n_in, void* d_out, int out_size, void* d_ws, size_t ws_size, hipStream_t stream) {
    static int grid = 0;
    if (grid == 0) {
        if (n_in != 29 || out_size != T * D || ws_size < WS_END) { fprintf(stderr, "kernel_launch: unexpected shapes (n_in %d out %d ws %zu)\n", n_in, out_size, ws_size); grid = -1; return; }
        int dev = 0, cus = 0, per_cu = 0;
        if (hipGetDevice(&dev) != hipSuccess || hipDeviceGetAttribute(&cus, hipDeviceAttributeMultiprocessorCount, dev) != hipSuccess) { grid = -1; return; }
        if (hipFuncSetAttribute((const void*)fwd_kernel, hipFuncAttributeMaxDynamicSharedMemorySize, LDS_BYTES) != hipSuccess) { fprintf(stderr, "kernel_launch: hipFuncSetAttribute failed\n"); grid = -1; return; }
        if (hipOccupancyMaxActiveBlocksPerMultiprocessor(&per_cu, (const void*)fwd_kernel, NWAVES * 64, LDS_BYTES) != hipSuccess || per_cu < 1) fprintf(stderr, "kernel_launch: occupancy query says %d\n", per_cu);
        (void)hipGetLastError();
        grid = cus;
    }
    if (grid < 0) return;
    (void)hipMemsetAsync((char*)d_ws + WS_CTL, 0, CTL_ZERO_BYTES, stream);
    Args a{};
    for (int i = 0; i < 29; ++i) a.in[i] = d_in[i];
    a.out = (float*)d_out; a.ws = (unsigned char*)d_ws;
    for (int i = 0; i < 32; ++i) a.inv[i] = (float)pow(10000.0, -(double)i / 32.0);
    a.dbg = DBG_MODE; a.pad = 0;
    const int last = (DBG_MODE != 0) ? DBG_LAST : PH_DBG;
#if MK_ONE_LAUNCH
    if (DBG_MODE == 0) { a.ph_lo = 0; a.ph_hi = PH_DBG; hipLaunchKernelGGL(fwd_kernel, dim3(grid), dim3(NWAVES * 64), LDS_BYTES, stream, a); }
    else { a.ph_lo = 0; a.ph_hi = last; hipLaunchKernelGGL(fwd_kernel, dim3(grid), dim3(NWAVES * 64), LDS_BYTES, stream, a);
           a.ph_lo = PH_DBG; a.ph_hi = PH_DBG + 1; hipLaunchKernelGGL(fwd_kernel, dim3(grid), dim3(NWAVES * 64), LDS_BYTES, stream, a); }
#else
    for (int p = 0; p < last; ++p) { a.ph_lo = p; a.ph_hi = p + 1; hipLaunchKernelGGL(fwd_kernel, dim3(grid), dim3(NWAVES * 64), LDS_BYTES, stream, a); }
    if (DBG_MODE != 0) { a.ph_lo = PH_DBG; a.ph_hi = PH_DBG + 1; hipLaunchKernelGGL(fwd_kernel, dim3(grid), dim3(NWAVES * 64), LDS_BYTES, stream, a); }
#endif
}
```
